# Optimizing an MI355X kernel written in HIP

```python
import jax, jax.numpy as jnp
from jax import lax
import numpy as np

D_MODEL = 1024
BATCH = 16
SEQ = 2048
DEPTH = 4

GRID_W = 64
CTX_LEN = 256
D_MIX = 1024
HEAD_DIM = 64
EPS = 1e-6
A_GROUPS = 4
A_WIDTH = A_GROUPS * HEAD_DIM
CHUNK = 128
B_HEADS = 8
B_KV_HEADS = 2
B_GROUP = B_HEADS // B_KV_HEADS
B_WIDTH = B_HEADS * HEAD_DIM
B_KV_WIDTH = B_KV_HEADS * HEAD_DIM
Q_BLOCK = 128
ATTN_SCALE = HEAD_DIM ** -0.5
ROPE_THETA = 10000.0
HALF_ROT = HEAD_DIM // 2
ROPE_FREQS = HALF_ROT // 2
C_HEADS = 4
C_WIDTH = C_HEADS * HEAD_DIM
M_CHUNK = 128
F_BIAS_LO = 3.0
F_BIAS_HI = 6.0
SPLIT_SIZES = (A_WIDTH, A_WIDTH, A_WIDTH,
               B_WIDTH, B_KV_WIDTH, B_KV_WIDTH, B_WIDTH,
               C_WIDTH, C_WIDTH, C_WIDTH, C_WIDTH, C_WIDTH, 4 * C_HEADS)
D_IN = 3 * A_WIDTH + 2 * B_WIDTH + 2 * B_KV_WIDTH + 5 * C_WIDTH + 4 * C_HEADS

kernel_name = 'hybrid_gmlp_gqa_mlstm_dit_block'


def _rms_norm(x, g):
    xf = x.astype(jnp.float32)
    y = xf * lax.rsqrt(jnp.mean(xf * xf, axis=-1, keepdims=True) + EPS)
    return (y * g.astype(jnp.float32)).astype(x.dtype)


def _layer_norm(x):
    xf = x.astype(jnp.float32)
    mu = jnp.mean(xf, axis=-1, keepdims=True)
    var = jnp.mean(jnp.square(xf - mu), axis=-1, keepdims=True)
    return ((xf - mu) * lax.rsqrt(var + EPS)).astype(x.dtype)


def _split_proj(p):
    idx = [int(i) for i in np.cumsum(SPLIT_SIZES)[:-1]]
    return jnp.split(p, idx, axis=-1)


def _rope_tables(rows_n):
    row = jnp.repeat(jnp.arange(rows_n, dtype=jnp.int32), GRID_W)
    col = jnp.tile(jnp.arange(GRID_W, dtype=jnp.int32), rows_n)
    freqs = ROPE_THETA ** (-jnp.arange(ROPE_FREQS, dtype=jnp.float32) / ROPE_FREQS)
    ang_r = row.astype(jnp.float32)[:, None] * freqs
    ang_c = col.astype(jnp.float32)[:, None] * freqs
    return (jnp.cos(ang_r), jnp.sin(ang_r), jnp.cos(ang_c), jnp.sin(ang_c))


def _apply_rope(x, tabs):
    cos_r, sin_r, cos_c, sin_c = tabs
    shp = (1, x.shape[1]) + (1,) * (x.ndim - 3) + (ROPE_FREQS,)
    xf = x.astype(jnp.float32)

    def rot(xh, cos, sin):
        cos = cos.reshape(shp)
        sin = sin.reshape(shp)
        x1, x2 = xh[..., :ROPE_FREQS], xh[..., ROPE_FREQS:]
        return jnp.concatenate([x1 * cos - x2 * sin, x2 * cos + x1 * sin], axis=-1)

    out = jnp.concatenate([rot(xf[..., :HALF_ROT], cos_r, sin_r),
                           rot(xf[..., HALF_ROT:], cos_c, sin_c)], axis=-1)
    return out.astype(x.dtype)


def _attend(q, k, v):
    s = jnp.einsum('bqkgd,bskd->bkgqs', q, k).astype(jnp.float32) * ATTN_SCALE
    p = jax.nn.softmax(s, axis=-1).astype(v.dtype)
    return jnp.einsum('bkgqs,bskd->bqkgd', p, v)


def _gmlp_branch(u, v, z, w_s, b_s):
    B_, T, _ = u.shape
    shp = (B_, T // CHUNK, CHUNK, A_GROUPS, HEAD_DIM)
    vn = _layer_norm(jax.nn.gelu(v).reshape(shp))
    sv = jnp.einsum('gpq,bcqgd->bcpgd', w_s, vn) + b_s.T[:, :, None]
    return (jax.nn.gelu(u).reshape(shp) * sv).reshape(B_, T, A_WIDTH) * jax.nn.silu(z)


def _mlstm_scan(q, k, v, log_i, log_f, state, emit_h):
    B_, T, H, D = q.shape
    nc = T // M_CHUNK

    def chunks(a):
        return a.reshape((B_, nc, M_CHUNK) + a.shape[2:]).swapaxes(0, 1)

    xs = (chunks(q), chunks(k), chunks(v), chunks(log_i), chunks(log_f))
    lower = jnp.tril(jnp.ones((M_CHUNK, M_CHUNK), dtype=bool))[None, :, :, None]

    def step(carry, inp):
        C, n, m = carry
        qc, kc, vc, li, lf = inp
        qf = qc.astype(jnp.float32)
        kf = kc.astype(jnp.float32) * (D ** -0.5)
        vf = vc.astype(jnp.float32)
        b = jnp.cumsum(lf, axis=1)
        b_end = b[:, -1]
        w_end = b_end[:, None] - b + li
        m_new = jnp.maximum(b_end + m, jnp.max(w_end, axis=1))
        decay = jnp.exp(b_end + m - m_new)
        wk = jnp.exp(w_end - m_new[:, None])
        C_new = decay[..., None, None] * C + jnp.einsum('blh,blhd,blhe->bhde', wk, vf, kf)
        n_new = decay[..., None] * n + jnp.einsum('blh,blhe->bhe', wk, kf)
        h = None
        if emit_h:
            a = b + m[:, None]
            dmat = b[:, :, None] - b[:, None] + li[:, None]
            dmat = jnp.where(lower, dmat, -jnp.inf)
            m_t = jnp.maximum(a, jnp.max(dmat, axis=2))
            inter = jnp.exp(a - m_t)
            s = jnp.einsum('bthd,bshd->btsh', qf, kf) * jnp.exp(dmat - m_t[:, :, None])
            num = jnp.einsum('btsh,bshd->bthd', s, vf) + inter[..., None] * jnp.einsum('bhde,bthe->bthd', C, qf)
            den = jnp.sum(s, axis=2) + inter * jnp.einsum('bhe,bthe->bth', n, qf)
            h = num / jnp.maximum(jnp.abs(den), jnp.exp(-m_t))[..., None]
        return (C_new, n_new, m_new), h

    state, hs = lax.scan(step, state, xs)
    h = hs.swapaxes(0, 1).reshape(B_, T, H, D).astype(q.dtype) if emit_h else None
    return h, state


def _layer(x, ctx, mod_lat, mod_ctx, tabs, g_norm, w_in, w_s, b_s, g_q, g_k, b_gates, g_head, w_out,
           with_ctx_out):
    B_, S, _ = x.shape
    Lc = ctx.shape[1]
    sh, sc, gt = jnp.split(mod_lat, 3, axis=-1)
    sh_c, sc_c, gt_c = jnp.split(mod_ctx, 3, axis=-1)
    xn = _rms_norm(x, g_norm) * (1 + sc[:, None]) + sh[:, None]
    cn = _rms_norm(ctx, g_norm) * (1 + sc_c) + sh_c
    (au, av, az, bq, bk, bv, bz, cq, ck, cv, co, cz, cg) = _split_proj(xn @ w_in)
    (au_c, av_c, az_c, bq_c, bk_c, bv_c, bz_c, cq_c, ck_c, cv_c, co_c, cz_c, cg_c) = _split_proj(cn @ w_in)

    def heads_q(t):
        return _rms_norm(t.reshape(t.shape[:2] + (B_KV_HEADS, B_GROUP, HEAD_DIM)), g_q)

    def heads_k(t):
        return _rms_norm(t.reshape(t.shape[:2] + (B_KV_HEADS, HEAD_DIM)), g_k)

    q_lat = _apply_rope(heads_q(bq), tabs)
    k_lat = _apply_rope(heads_k(bk), tabs)
    v_lat = bv.reshape(B_, S, B_KV_HEADS, HEAD_DIM)
    k_ctx = heads_k(bk_c)
    v_ctx = bv_c.reshape(B_, Lc, B_KV_HEADS, HEAD_DIM)
    k_all = jnp.concatenate([k_ctx, k_lat], axis=1)
    v_all = jnp.concatenate([v_ctx, v_lat], axis=1)
    q_blocks = q_lat.reshape(B_, S // Q_BLOCK, Q_BLOCK, B_KV_HEADS, B_GROUP, HEAD_DIM).swapaxes(0, 1)
    o_lat = lax.map(lambda qb: _attend(qb, k_all, v_all), q_blocks)
    y_b = o_lat.swapaxes(0, 1).reshape(B_, S, B_WIDTH) * jax.nn.silu(bz)

    def mheads(t):
        return t.reshape(t.shape[:2] + (C_HEADS, HEAD_DIM))

    def gates(g):
        g = g.astype(jnp.float32) + b_gates.astype(jnp.float32)
        i_f, f_f, i_b, f_b = jnp.split(g, 4, axis=-1)
        return i_f, jax.nn.log_sigmoid(f_f), i_b, jax.nn.log_sigmoid(f_b)

    def flip(t):
        return jnp.flip(t, axis=1)

    ql, kl, vl = mheads(cq), mheads(ck), mheads(cv)
    qc_, kc_, vc_ = mheads(cq_c), mheads(ck_c), mheads(cv_c)
    li_f, lf_f, li_b, lf_b = gates(cg)
    ci_f, cf_f, ci_b, cf_b = gates(cg_c)
    st0 = (jnp.zeros((B_, C_HEADS, HEAD_DIM, HEAD_DIM), jnp.float32),
           jnp.zeros((B_, C_HEADS, HEAD_DIM), jnp.float32),
           jnp.zeros((B_, C_HEADS), jnp.float32))
    h_cf, st_f = _mlstm_scan(qc_, kc_, vc_, ci_f, cf_f, st0, with_ctx_out)
    h_cb, st_b = _mlstm_scan(flip(qc_), flip(kc_), flip(vc_), flip(ci_b), flip(cf_b), st0, with_ctx_out)
    h_lf, _ = _mlstm_scan(ql, kl, vl, li_f, lf_f, st_f, True)
    h_lb, _ = _mlstm_scan(flip(ql), flip(kl), flip(vl), flip(li_b), flip(lf_b), st_b, True)
    g_hd = g_head.reshape(C_HEADS, HEAD_DIM)
    h_lat = _rms_norm(h_lf + flip(h_lb), g_hd).reshape(B_, S, C_WIDTH)
    y_c = jax.nn.sigmoid(co) * h_lat * jax.nn.silu(cz)

    y_a = _gmlp_branch(au, av, az, w_s, b_s)

    x = x + gt[:, None] * (jnp.concatenate([y_a, y_b, y_c], axis=-1) @ w_out)

    if with_ctx_out:
        o_ctx = _attend(heads_q(bq_c), k_ctx, v_ctx).reshape(B_, Lc, B_WIDTH)
        y_b_c = o_ctx * jax.nn.silu(bz_c)
        h_ctx = _rms_norm(h_cf + flip(h_cb), g_hd).reshape(B_, Lc, C_WIDTH)
        y_c_c = jax.nn.sigmoid(co_c) * h_ctx * jax.nn.silu(cz_c)
        y_a_c = _gmlp_branch(au_c, av_c, az_c, w_s, b_s)
        ctx = ctx + gt_c * (jnp.concatenate([y_a_c, y_b_c, y_c_c], axis=-1) @ w_out)
    return x, ctx


def setup_inputs(seed: int = 0) -> dict:
    key = jax.random.key(seed)
    ks = jax.random.split(key, 16)
    f32 = jnp.float32

    def nrm(k, shape, scale):
        return jax.random.normal(k, shape, f32) * scale

    f_bias = jnp.linspace(F_BIAS_LO, F_BIAS_HI, C_HEADS, dtype=f32)
    zeros_h = jnp.zeros((C_HEADS,), f32)
    gate_base = jnp.concatenate([zeros_h, f_bias, zeros_h, f_bias])
    return {
        'x': nrm(ks[0], (BATCH, SEQ, D_MODEL), 1.0),
        'c': nrm(ks[1], (BATCH, D_MODEL), 1.0),
        'ctx': nrm(ks[2], (BATCH, CTX_LEN, D_MODEL), 1.0),
        'c_ctx': nrm(ks[3], (D_MODEL,), 1.0),
        'w_ada': nrm(ks[4], (DEPTH, D_MODEL, 3 * D_MODEL), 0.5 * D_MODEL ** -0.5),
        'b_ada': nrm(ks[5], (DEPTH, 3 * D_MODEL), 0.01),
        'g_norm': 1.0 + nrm(ks[6], (DEPTH, D_MODEL), 0.02),
        'w_in': nrm(ks[7], (DEPTH, D_MODEL, D_IN), D_MODEL ** -0.5),
        'w_s': nrm(ks[8], (DEPTH, A_GROUPS, CHUNK, CHUNK), CHUNK ** -0.5),
        'b_s': 1.0 + nrm(ks[9], (DEPTH, A_GROUPS, CHUNK), 0.02),
        'g_q': 1.0 + nrm(ks[10], (DEPTH, HEAD_DIM), 0.02),
        'g_k': 1.0 + nrm(ks[11], (DEPTH, HEAD_DIM), 0.02),
        'b_gates': gate_base + nrm(ks[12], (DEPTH, 4 * C_HEADS), 0.1),
        'g_head': 1.0 + nrm(ks[13], (DEPTH, C_WIDTH), 0.02),
        'w_out': nrm(ks[14], (DEPTH, D_MIX, D_MODEL), D_MIX ** -0.5),
        'g_final': 1.0 + nrm(ks[15], (D_MODEL,), 0.02),
    }


def reference(x, c, ctx, c_ctx, w_ada, b_ada, g_norm, w_in, w_s, b_s, g_q, g_k, b_gates, g_head, w_out,
              g_final):
    ROWS = x.shape[1] // GRID_W
    tabs = _rope_tables(ROWS)
    silu_c = jax.nn.silu(c)
    silu_cc = jax.nn.silu(c_ctx)
    for l in range(DEPTH):
        mod_lat = silu_c @ w_ada[l] + b_ada[l]
        mod_ctx = silu_cc @ w_ada[l] + b_ada[l]
        x, ctx = _layer(x, ctx, mod_lat, mod_ctx, tabs, g_norm[l], w_in[l], w_s[l], b_s[l], g_q[l], g_k[l],
                        b_gates[l], g_head[l], w_out[l], with_ctx_out=(l < DEPTH - 1))
    return _rms_norm(x, g_final)
```

```cpp
#define FAST_ATTN 1
#define FAST_GMLP 1
#define FAST_MLSTM 1
#define ONE_LAUNCH 1
#include <hip/hip_runtime.h>
#include <cstdio>
#include <cstdint>

#ifndef FAST_ATTN
#define FAST_ATTN 0
#endif
#ifndef FAST_GMLP
#define FAST_GMLP 0
#endif
#ifndef FAST_MLSTM
#define FAST_MLSTM 0
#endif
#ifndef ONE_LAUNCH
#define ONE_LAUNCH 0
#endif
#ifndef PROBE_NOEPI
#define PROBE_NOEPI 0
#endif
#ifndef PROBE_MIX
#define PROBE_MIX 15
#endif
#ifndef PROBE_NOSTORE
#define PROBE_NOSTORE 0
#endif
#ifndef PROBE_LIM
#define PROBE_LIM 0
#endif
#ifndef WT_STORES
#define WT_STORES 0
#endif
#ifndef PROBE_XBAR
#define PROBE_XBAR 0
#endif
#ifndef PROBE_BF16
#define PROBE_BF16 0
#endif
#ifndef PROBE_DUP
#define PROBE_DUP 0
#endif
#define LAS __attribute__((address_space(3)))
#define GAS __attribute__((address_space(1)))
typedef _Float16 h16;
typedef _Float16 h16x8 __attribute__((ext_vector_type(8)));
typedef _Float16 h16x4 __attribute__((ext_vector_type(4)));
typedef _Float16 h16x2 __attribute__((ext_vector_type(2)));
typedef float f32x2 __attribute__((ext_vector_type(2)));
typedef float f32x4 __attribute__((ext_vector_type(4)));
typedef float f32x16 __attribute__((ext_vector_type(16)));
typedef unsigned u32x4 __attribute__((ext_vector_type(4)));
typedef unsigned u32x2 __attribute__((ext_vector_type(2)));
typedef short s16x4 __attribute__((ext_vector_type(4)));
typedef short v4i16_t __attribute__((ext_vector_type(4)));

constexpr int D = 1024, NB = 16, SEQ = 2048, DEPTH = 4, CTXL = 256, DIN = 3344, NPAD = 3584;
constexpr int MLAT = NB * SEQ, MCTX = NB * CTXL, MROWS = MLAT + MCTX;
constexpr int NKEY = CTXL + SEQ;
constexpr int NCHUNK = 18;
constexpr float EPS = 1e-6f;
constexpr float QSCALE = 0.125f * 1.4426950408889634f;

constexpr size_t MiB = 1u << 20;
constexpr size_t WS_CTL = 0, CTL_ZERO_BYTES = 1 * MiB;
constexpr size_t WS_WINT = 1 * MiB;
constexpr size_t WS_WOT = 29 * MiB;
constexpr size_t WS_WS16 = 37 * MiB;
constexpr size_t WS_MOD = WS_WS16 + MiB / 2;
constexpr size_t WS_SHW = WS_MOD + MiB;
constexpr size_t WS_AMOD = WS_SHW + MiB;
constexpr size_t WS_ROPE = WS_AMOD + MiB / 2;
constexpr size_t WS_ROWSQ = WS_ROPE + MiB / 2;
constexpr size_t WS_G = WS_ROWSQ + 5 * MiB / 2;
constexpr size_t WS_XC = WS_G + 5 * MiB / 2;
constexpr size_t WS_XS = WS_XC + 16 * MiB;
constexpr size_t WS_GU = WS_XS + 72 * MiB;
constexpr size_t WS_VN = WS_GU + 18 * MiB;
constexpr size_t WS_SZ = WS_VN + 18 * MiB;
constexpr size_t WS_Q = WS_SZ + 18 * MiB;
constexpr size_t WS_BZ = WS_Q + 36 * MiB;
constexpr size_t WS_KB = WS_BZ + 36 * MiB;
constexpr size_t WS_VB = WS_KB + 9 * MiB;
constexpr size_t WS_CQ = WS_VB + 9 * MiB;
constexpr size_t WS_CK = WS_CQ + 18 * MiB;
constexpr size_t WS_CV = WS_CK + 18 * MiB;
constexpr size_t WS_CO = WS_CV + 18 * MiB;
constexpr size_t WS_CZ = WS_CO + 18 * MiB;
constexpr size_t WS_X16 = WS_CZ + 18 * MiB;
constexpr size_t WS_ST = WS_X16 + 72 * MiB;
constexpr size_t ST_STRIDE = 8192 + 512;
constexpr size_t WS_HF = WS_ST + 20 * MiB;
constexpr size_t WS_HB = WS_HF + 18 * MiB;
constexpr size_t WS_END = WS_HB + 18 * MiB;
static_assert(WS_END <= 512 * MiB, "d_ws map");
static_assert((size_t)NB * 4 * 2 * NCHUNK * ST_STRIDE <= 20 * MiB, "state region");

constexpr int CW_TMO = 0;
constexpr int CW_BAR = 4096;
constexpr int CW_QUEUE = 16384;
constexpr int CW_CHAIN = 32768;

struct Ptrs {
    const float *x, *c, *ctx, *cctx, *wada, *bada, *gnorm, *win, *wsp, *bsp, *gq, *gk, *bgates, *ghead, *wout, *gfinal;
    float* out; unsigned char* ws;
};

__device__ __forceinline__ float siluf(float x) { return x * __builtin_amdgcn_rcpf(1.f + __builtin_amdgcn_exp2f(-1.4426950408889634f * x)); }
__device__ __forceinline__ float sigmf(float x) { return __builtin_amdgcn_rcpf(1.f + __builtin_amdgcn_exp2f(-1.4426950408889634f * x)); }
__device__ __forceinline__ float geluf(float x) { return x * __builtin_amdgcn_rcpf(1.f + __builtin_amdgcn_exp2f(x * (-0.10294324f * x * x - 2.3022082f))); }
__device__ __forceinline__ float logsigf(float x) { return fminf(x, 0.f) - 0.6931471805599453f * __builtin_amdgcn_logf(1.f + __builtin_amdgcn_exp2f(-1.4426950408889634f * fabsf(x))); }
__device__ __forceinline__ float lx_xor(float v, int m, int lane) { return __int_as_float(__builtin_amdgcn_ds_bpermute((lane ^ m) << 2, __float_as_int(v))); }
__device__ __forceinline__ float lx_up(float v, int o, int lane) { return __int_as_float(__builtin_amdgcn_ds_bpermute((lane - o) << 2, __float_as_int(v))); }
__device__ __forceinline__ float lx_get(float v, int src) { return __int_as_float(__builtin_amdgcn_readlane(__float_as_int(v), src)); }
template <int CTRL, int ROWMASK = 0xF> __device__ __forceinline__ float dpp_f(float old, float v) { return __int_as_float(__builtin_amdgcn_update_dpp(__float_as_int(old), __float_as_int(v), CTRL, ROWMASK, 0xF, false)); }
__device__ __forceinline__ float quad_sum(float s) { s += dpp_f<0xB1>(0.f, s); s += dpp_f<0x4E>(0.f, s); return s; }
__device__ __forceinline__ float oct_sum(float s) { s = quad_sum(s); s += dpp_f<0x141>(0.f, s); return s; }
__device__ __forceinline__ unsigned cvtpk_h(float lo, float hi) { f32x2 v = {lo, hi}; h16x2 b = __builtin_convertvector(v, h16x2); return __builtin_bit_cast(unsigned, b); }
namespace pg8 {
typedef __bf16 bf16x8_t __attribute__((ext_vector_type(8)));
constexpr int BM = 256, BK = 64, HALF = 128, HTB = HALF * BK * 2, STAGE_BYTES = 8 * HTB, NXCD = 8, WGM = 8;
__host__ __device__ __forceinline__ int lds_byte(int r, int c) { const int st = (r >> 4) * 2 + (c >> 5), rr = r & 15, cc = c & 31, ob = rr * 64 + cc * 2; return st * 1024 + (ob ^ (((ob >> 9) & 1) << 5)); }
__host__ __device__ __forceinline__ void stage_rc(int b, int& R, int& C) { const int st = b / 1024, sb = b % 1024, swz = sb ^ (((sb >> 9) & 1) << 5); R = (st >> 1) * 16 + swz / 64; C = (st & 1) * 32 + (swz % 64) / 2; }
struct Unit { int pm, pn; };
struct Gemm { const h16* A; const h16* Bt; int M, N, K; };
struct StaticOrder {
    int nM, nN, nwg, G, c;
    __host__ __device__ void init(int M, int N, int G_, int c_) { nM = M / BM; nN = N / BM; nwg = nM * nN; G = G_; c = c_; }
    __host__ __device__ bool next(int i, Unit& u) const {
        const long L = (long)i * G + c; if (L >= nwg) return false;
        int wgid = (int)L; { const int q = nwg / NXCD, r = nwg % NXCD, xcd = wgid % NXCD, off = wgid / NXCD; wgid = (xcd < r ? xcd * (q + 1) : r * (q + 1) + (xcd - r) * q) + off; }
        const int nig = WGM * nN, gid = wgid / nig, fm = gid * WGM, gsz = (nM - fm) < WGM ? (nM - fm) : WGM;
        u.pm = fm + ((wgid % nig) % gsz); u.pn = (wgid % nig) / gsz; return true;
    }
};
template <class Epi, bool ALIGN_EPI, bool SP2, bool BF = false>
__device__ __forceinline__ void gemm_phase(LAS unsigned char* lds, const int tid, const Gemm g, const StaticOrder& S, const Epi& E, const bool dry = false) {
    const int wid = __builtin_amdgcn_readfirstlane(tid >> 6), lane = tid & 63, wr = wid >> 2, wc = wid & 3, fr = lane & 15, fq = lane >> 4;
    const int K = g.K, nt = K / BK;
    unsigned voffA[2];
#pragma unroll
    for (int i = 0; i < 2; ++i) { int R, C; stage_rc(tid * 16 + i * 8192, R, C); voffA[i] = (unsigned)(R * K + C) * 2u; }
    const size_t kstep = (size_t)(BK * 2);
    const size_t hstep = (size_t)HALF * K * 2;
    const size_t tstep = 2 * hstep;
    const unsigned ldsw = (unsigned)wid * 1024u;
    const int aoff = lds_byte(wr * 64 + fr, fq * 8), boff = lds_byte(wc * 32 + fr, fq * 8);
#define PG8_SA(b, h) (((b) * 2 + (h)) * HTB)
#define PG8_SB(b, h) ((4 + (b) * 2 + (h)) * HTB)
#define PG8_STAGE(bufoff, gbase) do { _Pragma("unroll") for (int _i = 0; _i < 2; ++_i) \
        __builtin_amdgcn_global_load_lds((const unsigned*)((const char*)(gbase) + voffA[_i]), (LAS unsigned*)(lds + (bufoff) + ldsw + _i * 8192), 16, 0, 0); } while (0)
#define PG8_LDA(dst, b, h) do { _Pragma("unroll") for (int m = 0; m < 4; ++m) _Pragma("unroll") for (int k = 0; k < 2; ++k) dst[m][k] = *(const LAS h16x8*)(lds + PG8_SA(b, h) + aoff + m * 2048 + k * 1024); } while (0)
#define PG8_LDB(dst, b, h) do { _Pragma("unroll") for (int n = 0; n < 2; ++n) _Pragma("unroll") for (int k = 0; k < 2; ++k) dst[n][k] = *(const LAS h16x8*)(lds + PG8_SB(b, h) + boff + n * 2048 + k * 1024); } while (0)
#define PG8_MMA(ai, bj, At, Bt) do { __builtin_amdgcn_s_setprio(1); _Pragma("unroll") for (int m = 0; m < 4; ++m) _Pragma("unroll") for (int n = 0; n < 2; ++n) _Pragma("unroll") for (int k = 0; k < 2; ++k) \
        acc[ai][bj][m][n] = BF ? __builtin_amdgcn_mfma_f32_16x16x32_bf16(__builtin_bit_cast(bf16x8_t, Bt[n][k]), __builtin_bit_cast(bf16x8_t, At[m][k]), acc[ai][bj][m][n], 0, 0, 0) : __builtin_amdgcn_mfma_f32_16x16x32_f16(Bt[n][k], At[m][k], acc[ai][bj][m][n], 0, 0, 0); __builtin_amdgcn_s_setprio(0); } while (0)
#define PG8_WAIT_V(n) asm volatile("s_waitcnt vmcnt(" #n ")" ::: "memory")
#define PG8_WAIT_L(n) asm volatile("s_waitcnt lgkmcnt(" #n ")" ::: "memory")
#define PG8_BAR __builtin_amdgcn_s_barrier()
#define PG8_SCHED __builtin_amdgcn_sched_barrier(0)
    Unit cur, nxt; int ui = 0;
    if (!S.next(0, cur)) return;
    f32x4 acc[2][2][4][2];
#pragma unroll
    for (int a = 0; a < 2; ++a)
#pragma unroll
        for (int b = 0; b < 2; ++b)
#pragma unroll
            for (int m = 0; m < 4; ++m)
#pragma unroll
                for (int n = 0; n < 2; ++n) acc[a][b][m][n] = (f32x4){0.f, 0.f, 0.f, 0.f};
    h16x8 At[4][2], B0[2][2], B1[2][2];
    const char* cA = (const char*)g.A + (size_t)cur.pm * tstep; const char* cB = (const char*)g.Bt + (size_t)cur.pn * tstep;
    if constexpr (SP2) {
        PG8_STAGE(PG8_SB(0, 0), cB); PG8_STAGE(PG8_SB(0, 1), cB + hstep); PG8_STAGE(PG8_SA(0, 0), cA); PG8_STAGE(PG8_SA(0, 1), cA + hstep);
        if (wr == 1) PG8_BAR;
        PG8_WAIT_V(2); PG8_BAR;
        PG8_STAGE(PG8_SB(1, 0), cB + kstep); PG8_STAGE(PG8_SA(1, 0), cA + kstep); PG8_STAGE(PG8_SB(1, 1), cB + hstep + kstep);
        PG8_WAIT_V(6); PG8_BAR;
    } else {
        PG8_STAGE(PG8_SB(0, 0), cB); PG8_STAGE(PG8_SA(0, 0), cA); PG8_STAGE(PG8_SB(0, 1), cB + hstep); PG8_STAGE(PG8_SA(0, 1), cA + hstep);
        if (wr == 1) PG8_BAR;
        PG8_WAIT_V(4); PG8_BAR;
        PG8_STAGE(PG8_SB(1, 0), cB + kstep); PG8_STAGE(PG8_SA(1, 0), cA + kstep); PG8_STAGE(PG8_SB(1, 1), cB + hstep + kstep);
        PG8_WAIT_V(6); PG8_BAR;
    }
    for (;;) {
        const bool has_next = S.next(ui + 1, nxt);
        const char* nA = has_next ? (const char*)g.A + (size_t)nxt.pm * tstep : cA; const char* nB = has_next ? (const char*)g.Bt + (size_t)nxt.pn * tstep : cB;
        for (int t = 0; t < nt; t += 2) {
            const bool last = (t == nt - 2);
            const char* a1 = cA + (size_t)(t + 1) * kstep;
            const char* a2 = last ? nA : cA + (size_t)(t + 2) * kstep; const char* b2 = last ? nB : cB + (size_t)(t + 2) * kstep;
            const char* a3 = a2 + kstep; const char* b3 = b2 + kstep;
            if constexpr (SP2) {
            PG8_LDB(B0, 0, 0); PG8_LDB(B1, 0, 1); PG8_SCHED; PG8_LDA(At, 0, 0); PG8_STAGE(PG8_SA(1, 1), a1 + hstep);
            PG8_WAIT_V(8); PG8_WAIT_L(0); PG8_BAR; PG8_MMA(0, 0, At, B0); PG8_MMA(0, 1, At, B1); PG8_BAR; PG8_SCHED;
            PG8_LDA(At, 0, 1); PG8_STAGE(PG8_SB(0, 0), b2); PG8_STAGE(PG8_SB(0, 1), b2 + hstep); PG8_STAGE(PG8_SA(0, 0), a2);
            PG8_WAIT_V(8); PG8_WAIT_L(0); PG8_BAR; PG8_MMA(1, 0, At, B0); PG8_MMA(1, 1, At, B1); PG8_BAR; PG8_SCHED;
            PG8_LDB(B0, 1, 0); PG8_LDB(B1, 1, 1); PG8_SCHED; PG8_LDA(At, 1, 0); PG8_STAGE(PG8_SA(0, 1), a2 + hstep);
            PG8_WAIT_V(8); PG8_WAIT_L(0); PG8_BAR; PG8_MMA(0, 0, At, B0); PG8_MMA(0, 1, At, B1); PG8_BAR; PG8_SCHED;
            PG8_LDA(At, 1, 1); PG8_STAGE(PG8_SB(1, 0), b3); PG8_STAGE(PG8_SB(1, 1), b3 + hstep); PG8_STAGE(PG8_SA(1, 0), a3);
            PG8_WAIT_V(8); PG8_WAIT_L(0); PG8_BAR; PG8_MMA(1, 0, At, B0); PG8_MMA(1, 1, At, B1); PG8_BAR; PG8_SCHED;
            } else {
            PG8_LDB(B0, 0, 0); PG8_SCHED; PG8_LDA(At, 0, 0); PG8_STAGE(PG8_SA(1, 1), a1 + hstep);
            PG8_WAIT_L(8); PG8_BAR; PG8_WAIT_L(0); PG8_MMA(0, 0, At, B0); PG8_BAR; PG8_SCHED;
            PG8_LDB(B1, 0, 1); PG8_STAGE(PG8_SB(0, 0), b2);
            PG8_BAR; PG8_WAIT_L(0); PG8_MMA(0, 1, At, B1); PG8_BAR;
            PG8_LDA(At, 0, 1); PG8_STAGE(PG8_SA(0, 0), a2);
            PG8_BAR; PG8_WAIT_L(0); PG8_MMA(1, 0, At, B0); PG8_BAR; PG8_SCHED;
            PG8_STAGE(PG8_SB(0, 1), b2 + hstep);
            PG8_WAIT_V(6); PG8_BAR; PG8_MMA(1, 1, At, B1); PG8_BAR;
            PG8_LDB(B0, 1, 0); PG8_SCHED; PG8_LDA(At, 1, 0); PG8_STAGE(PG8_SA(0, 1), a2 + hstep);
            PG8_WAIT_L(8); PG8_BAR; PG8_WAIT_L(0); PG8_MMA(0, 0, At, B0); PG8_BAR; PG8_SCHED;
            PG8_LDB(B1, 1, 1); PG8_STAGE(PG8_SB(1, 0), b3);
            PG8_BAR; PG8_WAIT_L(0); PG8_MMA(0, 1, At, B1); PG8_BAR;
            PG8_LDA(At, 1, 1); PG8_STAGE(PG8_SA(1, 0), a3);
            PG8_BAR; PG8_WAIT_L(0); PG8_MMA(1, 0, At, B0); PG8_BAR; PG8_SCHED;
            PG8_STAGE(PG8_SB(1, 1), b3 + hstep);
            PG8_WAIT_V(6); PG8_BAR; PG8_MMA(1, 1, At, B1); PG8_BAR;
            }
        }
        if constexpr (ALIGN_EPI) { if (wr == 0) PG8_BAR; }
        if (!dry) { int fr2 = fr, fq2 = fq; asm volatile("" : "+v"(fr2), "+v"(fq2)); E(acc, cur, wr, wc, fr2, fq2); }
        else { _Pragma("unroll") for (int a_ = 0; a_ < 2; ++a_) _Pragma("unroll") for (int b_ = 0; b_ < 2; ++b_) _Pragma("unroll") for (int m_ = 0; m_ < 4; ++m_) _Pragma("unroll") for (int n_ = 0; n_ < 2; ++n_) asm volatile("" :: "v"(acc[a_][b_][m_][n_])); }
        if (!has_next) break;
#pragma unroll
        for (int a = 0; a < 2; ++a)
#pragma unroll
            for (int b = 0; b < 2; ++b)
#pragma unroll
                for (int m = 0; m < 4; ++m)
#pragma unroll
                    for (int n = 0; n < 2; ++n) acc[a][b][m][n] = (f32x4){0.f, 0.f, 0.f, 0.f};
        cur = nxt; cA = nA; cB = nB; ++ui;
        if constexpr (ALIGN_EPI) { if (wr == 1) PG8_BAR; }
    }
    PG8_WAIT_V(0);
    if constexpr (!ALIGN_EPI) { if (wr == 0) PG8_BAR; }
    PG8_BAR;
#undef PG8_SA
#undef PG8_SB
#undef PG8_STAGE
#undef PG8_LDA
#undef PG8_LDB
#undef PG8_MMA
#undef PG8_WAIT_V
#undef PG8_WAIT_L
#undef PG8_BAR
#undef PG8_SCHED
}
}

__host__ __device__ __forceinline__ int tile_pos_of_col(int ca, bool mapA) {
    const int wc = ca >> 6, d = ca & 63, bj = d >> 5, j = d & 3; int n, fq;
    if (mapA) { n = (d >> 4) & 1; fq = (d >> 2) & 3; } else { fq = (d >> 3) & 3; n = (d >> 2) & 1; }
    return 128 * bj + 32 * wc + 16 * n + 4 * fq + j;
}
__host__ __device__ __forceinline__ bool slab_is_mapA(int s) { return s >= 12 && s <= 21; }
__device__ __forceinline__ f32x4 ldg_f4(const void* base, unsigned off) { return *(const GAS f32x4*)((const GAS char*)base + off); }
__device__ __forceinline__ void stg_f4(void* base, unsigned off, f32x4 v) {
#if PROBE_NOSTORE
    if (base == nullptr) { asm volatile("" :: "v"(v)); return; }
#endif
#if WT_STORES
    asm volatile("global_store_dwordx4 %0, %1, %2 sc1\n\ts_nop 1" :: "v"(off), "v"(v), "s"(base) : "memory");
#else
    *(GAS f32x4*)((GAS char*)base + off) = v;
#endif
}
__device__ __forceinline__ void stg_u4(void* base, unsigned off, u32x4 v) {
#if PROBE_NOSTORE
    if (base == nullptr) { asm volatile("" :: "v"(v)); return; }
#endif
#if WT_STORES
    asm volatile("global_store_dwordx4 %0, %1, %2 sc1\n\ts_nop 1" :: "v"(off), "v"(v), "s"(base) : "memory");
#else
    *(GAS u32x4*)((GAS char*)base + off) = v;
#endif
}
__device__ __forceinline__ void stg_u2(void* base, unsigned off, u32x2 v) {
#if PROBE_NOSTORE
    if (base == nullptr) { asm volatile("" :: "v"(v)); return; }
#endif
    *(GAS u32x2*)((GAS char*)base + off) = v; }
__device__ __forceinline__ void stg_f1(void* base, unsigned off, float v) { *(GAS float*)((GAS char*)base + off) = v; }
__device__ __forceinline__ float red4(float s, int lane) {
    (void)lane;
    { auto r = __builtin_amdgcn_permlane16_swap(__float_as_uint(s), __float_as_uint(s), false, false); s = __uint_as_float(r[0]) + __uint_as_float(r[1]); }
    { auto r = __builtin_amdgcn_permlane32_swap(__float_as_uint(s), __float_as_uint(s), false, false); s = __uint_as_float(r[0]) + __uint_as_float(r[1]); }
    return s; }
struct ActP { float A, B, M0, M1; };
template <bool SIG> __device__ __forceinline__ float act_g(float x, const ActP& p) {
    const float ml = p.M1 * x + p.M0;
    if (!SIG) return ml;
    return ml * __builtin_amdgcn_rcpf(1.f + __builtin_amdgcn_exp2f(x * (p.A * (x * x) + p.B)));
}
template <bool SIG> __device__ __forceinline__ void epi_act_store(const f32x4 (&acc)[2][2][4][2], const float (&rs)[2][4], const f32x4 (&bv)[2][2], unsigned char* ws, unsigned off0, unsigned rowstep, const ActP p) {
#pragma unroll
    for (int ai = 0; ai < 2; ++ai)
#pragma unroll
        for (int m = 0; m < 4; ++m) { const unsigned ro = off0 + (unsigned)(ai * 8 + m) * rowstep; const float r = rs[ai][m];
#pragma unroll
            for (int bj = 0; bj < 2; ++bj) { const f32x4 v0 = acc[ai][bj][m][0] * r + bv[bj][0], v1 = acc[ai][bj][m][1] * r + bv[bj][1];
                u32x4 w; w.x = cvtpk_h(act_g<SIG>(v0[0], p), act_g<SIG>(v0[1], p)); w.y = cvtpk_h(act_g<SIG>(v0[2], p), act_g<SIG>(v0[3], p));
                w.z = cvtpk_h(act_g<SIG>(v1[0], p), act_g<SIG>(v1[1], p)); w.w = cvtpk_h(act_g<SIG>(v1[2], p), act_g<SIG>(v1[3], p));
                stg_u4(ws, ro + 64u * bj, w); }
            asm volatile("" ::: "memory"); }
}

struct EpiIn {
    unsigned shw_off  ; const float* gq; const float* gk; const float* bg; unsigned char* ws_; unsigned char* wst_  ; const LAS float* ropel;
    __device__ __forceinline__ void operator()(const f32x4 (&acc)[2][2][4][2], const pg8::Unit& u, int wr, int wc, int fr, int fq) const {
        const int s = u.pn * 4 + wc;
        if (s >= 53) return;
        unsigned char* ws = ws_; asm volatile("" : "+s"(ws)); unsigned char* wst = wst_ ? ws : nullptr;
        const bool lat = u.pm < 128; const int b = lat ? (u.pm >> 3) : (u.pm - 128); const int bb = lat ? b : 16;
        const int rloc = wr * 64 + fr;
        const unsigned rbase = (unsigned)u.pm * 256u + (unsigned)rloc;
        float rs[2][4];
        { f32x4 t[2][4];
#pragma unroll
          for (int ai = 0; ai < 2; ++ai)
#pragma unroll
            for (int m = 0; m < 4; ++m) t[ai][m] = ldg_f4(ws, (unsigned)WS_ROWSQ + (rbase + ai * 128 + m * 16) * 64u + 16u * fq);
#pragma unroll
          for (int ai = 0; ai < 2; ++ai)
#pragma unroll
            for (int m = 0; m < 4; ++m) rs[ai][m] = __builtin_amdgcn_rsqf(red4((t[ai][m][0] + t[ai][m][1]) + (t[ai][m][2] + t[ai][m][3]), fq * 16 + fr) * (1.f / 1024.f) + EPS); }
        const bool mapA = s >= 12 && s <= 21;
        f32x4 bv[2][2];
#pragma unroll
        for (int bj = 0; bj < 2; ++bj)
#pragma unroll
            for (int n = 0; n < 2; ++n) { const int doff = mapA ? (32 * bj + 16 * n + 4 * fq) : (32 * bj + 8 * fq + 4 * n); bv[bj][n] = ldg_f4(ws, shw_off + (unsigned)(bb * NPAD + s * 64 + doff) * 4u); }
        const int key0 = lat ? CTXL + (u.pm & 7) * 256 : 0;
        if (s < 12 || s >= 22) {
            if (s == 52) {
                if (fq < 2) { const f32x4 g0 = *(const GAS f32x4*)(bg + 8 * fq), g1 = *(const GAS f32x4*)(bg + 8 * fq + 4);
#pragma unroll
                    for (int ai = 0; ai < 2; ++ai)
#pragma unroll
                        for (int m = 0; m < 4; ++m) { const float r = rs[ai][m]; const f32x4 vi = acc[ai][0][m][0] * r + bv[0][0] + g0; f32x4 vf = acc[ai][0][m][1] * r + bv[0][1] + g1;
                            vf = (f32x4){logsigf(vf[0]), logsigf(vf[1]), logsigf(vf[2]), logsigf(vf[3])};
                            const unsigned go = (unsigned)WS_G + (rbase + ai * 128 + m * 16) * 64u + 32u * fq; stg_f4(wst, go, vi); stg_f4(wst, go + 16u, vf); } }
                return;
            }
            unsigned base, pitch, coff; int act; unsigned row0 = (unsigned)u.pm * 256u;
            if (s < 4) { base = (unsigned)WS_GU; pitch = 256; coff = s * 64; act = 1; }
            else if (s < 8) { base = (unsigned)WS_VN; pitch = 256; coff = (s - 4) * 64; act = 1; }
            else if (s < 12) { base = (unsigned)WS_SZ; pitch = 256; coff = (s - 8) * 64; act = 2; }
            else if (s < 24) { base = (unsigned)WS_VB; pitch = 64; coff = 0; act = 0; row0 = (unsigned)(b * 2 + (s - 22)) * NKEY + key0; }
            else if (s < 32) { base = (unsigned)WS_BZ; pitch = 512; coff = (s - 24) * 64; act = 2; }
            else if (s < 36) { base = (unsigned)WS_CQ; pitch = 256; coff = (s - 32) * 64; act = 0; }
            else if (s < 40) { base = (unsigned)WS_CK; pitch = 256; coff = (s - 36) * 64; act = 4; }
            else if (s < 44) { base = (unsigned)WS_CV; pitch = 256; coff = (s - 40) * 64; act = 0; }
            else if (s < 48) { base = (unsigned)WS_CO; pitch = 256; coff = (s - 44) * 64; act = 3; }
            else { base = (unsigned)WS_CZ; pitch = 256; coff = (s - 48) * 64; act = 2; }
            const unsigned off0 = base + ((row0 + rloc) * pitch + coff + 8u * fq) * 2u, rowstep = 32u * pitch;
            (void)act;
            epi_act_store<false>(acc, rs, bv, wst, off0, rowstep, ActP{0.f, 0.f, 0.f, act == 4 ? 0.125f : 1.f});
            return;
        }
        const bool isq = s < 20; const float* gv = isq ? gq : gk; const float osc = isq ? QSCALE : 1.f;
        f32x4 g4[2][2];
#pragma unroll
        for (int bj = 0; bj < 2; ++bj)
#pragma unroll
            for (int n = 0; n < 2; ++n) g4[bj][n] = *(const GAS f32x4*)(gv + 32 * bj + 16 * n + 4 * fq) * osc;
        const unsigned pitch = isq ? 512u : 64u;
        const unsigned off0 = isq ? (unsigned)WS_Q + (((unsigned)u.pm * 256u + rloc) * 512u + (s - 12) * 64 + 4u * fq) * 2u
                                  : (unsigned)WS_KB + (((unsigned)(b * 2 + (s - 20)) * NKEY + key0 + rloc) * 64u + 4u * fq) * 2u;
#pragma unroll
        for (int ai = 0; ai < 2; ++ai)
#pragma unroll
            for (int m = 0; m < 4; ++m) { const float r = rs[ai][m]; f32x4 v[2][2]; float ss = 0.f;
#pragma unroll
                for (int bj = 0; bj < 2; ++bj)
#pragma unroll
                    for (int n = 0; n < 2; ++n) { v[bj][n] = acc[ai][bj][m][n] * r + bv[bj][n]; ss += (v[bj][n][0] * v[bj][n][0] + v[bj][n][1] * v[bj][n][1]) + (v[bj][n][2] * v[bj][n][2] + v[bj][n][3] * v[bj][n][3]); }
                const float rn = __builtin_amdgcn_rsqf(red4(ss, fq * 16 + fr) * (1.f / 64.f) + EPS);
#pragma unroll
                for (int bj = 0; bj < 2; ++bj)
#pragma unroll
                    for (int n = 0; n < 2; ++n) v[bj][n] = v[bj][n] * rn * g4[bj][n];
                if (lat) { const unsigned t = (rbase + ai * 128 + m * 16) & (SEQ - 1);
#pragma unroll
                    for (int bj = 0; bj < 2; ++bj) { const unsigned pos = bj ? (t & 63u) : (t >> 6); const f32x4 cs = *(const LAS f32x4*)(ropel + pos * 16u + 4u * fq), sn = *(const LAS f32x4*)(ropel + 1024u + pos * 16u + 4u * fq);
                        const f32x4 x1 = v[bj][0], x2 = v[bj][1]; v[bj][0] = x1 * cs - x2 * sn; v[bj][1] = x2 * cs + x1 * sn; } }
                const unsigned ro = off0 + (unsigned)(ai * 8 + m) * 32u * pitch;
#pragma unroll
                for (int bj = 0; bj < 2; ++bj)
#pragma unroll
                    for (int n = 0; n < 2; ++n) { u32x2 w; w.x = cvtpk_h(v[bj][n][0], v[bj][n][1]); w.y = cvtpk_h(v[bj][n][2], v[bj][n][3]); stg_u2(wst, ro + 64u * bj + 32u * n, w); }
                asm volatile("" ::: "memory"); }
    }
};

struct EpiOut {
    unsigned gt_off  ; unsigned an_off  ; unsigned char* ws_; float gscale;
    __device__ __forceinline__ void operator()(const f32x4 (&acc)[2][2][4][2], const pg8::Unit& u, int wr, int wc, int fr, int fq) const {
        unsigned char* ws = ws_; asm volatile("" : "+s"(ws));
        const bool lat = u.pm < 128; const int bb = lat ? (u.pm >> 3) : 16;
        const unsigned rloc = wr * 64 + fr, col0 = u.pn * 256 + wc * 64 + 8 * fq;
        f32x4 g4[2][2], a4[2][2];
#pragma unroll
        for (int bj = 0; bj < 2; ++bj)
#pragma unroll
            for (int n = 0; n < 2; ++n) { g4[bj][n] = ldg_f4(ws, gt_off + ((unsigned)bb * 3072u + col0 + 32 * bj + 4 * n) * 4u) * gscale; a4[bj][n] = an_off ? ldg_f4(ws, an_off + ((unsigned)bb * 1024u + col0 + 32 * bj + 4 * n) * 4u) : (f32x4){0.f, 0.f, 0.f, 0.f}; }
        const unsigned eo = (((unsigned)u.pm * 256u + rloc) * D + col0) * 2u, rqo = (unsigned)WS_ROWSQ + (((unsigned)u.pm * 256u + rloc) * 16u + u.pn * 4 + wc) * 4u;
#pragma unroll
        for (int ai = 0; ai < 2; ++ai)
#pragma unroll
            for (int m = 0; m < 4; ++m) { const unsigned rr = (unsigned)(ai * 128 + m * 16); float ss = 0.f;
#pragma unroll
                for (int bj = 0; bj < 2; ++bj) { const unsigned o = eo + rr * (D * 2u) + 64u * bj;
                    const h16x8 xb = *(const GAS h16x8*)((const GAS char*)ws + (unsigned)WS_X16 + o);
                    const f32x4 x0 = (f32x4){(float)xb[0], (float)xb[1], (float)xb[2], (float)xb[3]} + g4[bj][0] * acc[ai][bj][m][0], x1 = (f32x4){(float)xb[4], (float)xb[5], (float)xb[6], (float)xb[7]} + g4[bj][1] * acc[ai][bj][m][1];
                    ss += ((x0[0] * x0[0] + x0[1] * x0[1]) + (x0[2] * x0[2] + x0[3] * x0[3])) + ((x1[0] * x1[0] + x1[1] * x1[1]) + (x1[2] * x1[2] + x1[3] * x1[3]));
                    u32x4 w; w.x = cvtpk_h(x0[0], x0[1]); w.y = cvtpk_h(x0[2], x0[3]); w.z = cvtpk_h(x1[0], x1[1]); w.w = cvtpk_h(x1[2], x1[3]); stg_u4(ws, (unsigned)WS_X16 + o, w);
                    if (an_off) { const f32x4 y0 = x0 * a4[bj][0], y1 = x1 * a4[bj][1]; u32x4 v; v.x = cvtpk_h(y0[0], y0[1]); v.y = cvtpk_h(y0[2], y0[3]); v.z = cvtpk_h(y1[0], y1[1]); v.w = cvtpk_h(y1[2], y1[3]); stg_u4(ws, (unsigned)WS_XS + o, v); } }
                ss = red4(ss, fq * 16 + fr); if (fq == 0) stg_f1(ws, rqo + rr * 64u, ss);
                if (m & 1) asm volatile("" ::: "memory"); }
    }
};
typedef GAS unsigned gu32;
#define RLX_AGENT __ATOMIC_RELAXED, __HIP_MEMORY_SCOPE_AGENT
#define LDS_WAIT() asm volatile("s_waitcnt lgkmcnt(0)" ::: "memory")
#define VM_WAIT() asm volatile("s_waitcnt vmcnt(0)" ::: "memory")
#define BAR_LDS() asm volatile("s_waitcnt lgkmcnt(0)\n\ts_barrier" ::: "memory")
constexpr int NWAVES = 8, NTHREADS = 512;
constexpr int RING_BYTES = 131072;
constexpr int MISC_OFF = RING_BYTES;
constexpr int ROPE_LDS_OFF = MISC_OFF + 1024;
constexpr int LDS_BYTES = 147456;

#define XB_TMO      128
#define XB_XCNT(j)  (256  + 64 * (j))
#define XB_XSUB(j)  (1280 + 64 * (j))
#define XB_XGEN(j)  (2304 + 64 * (j))
#define XB_TOP      3328
#define XB_TOPGEN   3392
#define XCD_BAR_WORDS 3456
#define XB_SPIN_CAP (1u << 20)
__device__ __forceinline__ unsigned xb_ld(unsigned* p)              { return __hip_atomic_load(p, __ATOMIC_RELAXED, __HIP_MEMORY_SCOPE_AGENT); }
__device__ __forceinline__ unsigned xb_add(unsigned* p, unsigned v) { return __hip_atomic_fetch_add(p, v, __ATOMIC_RELAXED, __HIP_MEMORY_SCOPE_AGENT); }
__device__ __forceinline__ unsigned xb_xcc_id() { return (unsigned)__builtin_amdgcn_s_getreg((3 << 11) | 20) & 0xFu; }
#define XB_SPIN(cond, bar) do { unsigned _sp = 0; while (cond) { __builtin_amdgcn_s_sleep(1); \
    if ((++_sp & 255u) == 0u) { if (xb_ld(&(bar)[XB_TMO])) break; if (_sp > XB_SPIN_CAP) { atomicAdd(&(bar)[XB_TMO], 1u); break; } } } } while (0)
struct XcdBarrier { unsigned* bar; unsigned x; volatile LAS unsigned* st; };
__device__ __forceinline__ XcdBarrier xcd_barrier_post(unsigned* bar, volatile LAS unsigned* st) {
    XcdBarrier b; b.bar = bar; b.x = xb_xcc_id(); b.st = st;
    if (threadIdx.x == 0) (void)xb_add(&bar[XB_XCNT(b.x)], 1u);
    return b;
}
__device__ __forceinline__ void xcd_barrier_complete(unsigned* bar, unsigned x, unsigned& nloc, unsigned& nx) {
    const unsigned G = gridDim.x * gridDim.y * gridDim.z;
    unsigned sum, cnt, mine, sp = 0u;
    for (;;) {
        sum = 0u; cnt = 0u; mine = 0u;
#pragma unroll
        for (unsigned j = 0; j < 16; ++j) { const unsigned c = xb_ld(&bar[XB_XCNT(j)]); sum += c; cnt += (c > 0u) ? 1u : 0u; mine = (j == x) ? c : mine; }
        if (sum == G) break;
        __builtin_amdgcn_s_sleep(1);
        if ((++sp & 255u) == 0u) { if (xb_ld(&bar[XB_TMO])) break; if (sp > XB_SPIN_CAP) { atomicAdd(&bar[XB_TMO], 1u); break; } }
    }
    nloc = mine > 0u ? mine : 1u; nx = cnt > 0u ? cnt : 1u;
}
__device__ __forceinline__ void xcd_barrier(const XcdBarrier& b) {
    asm volatile("s_waitcnt vmcnt(0)" ::: "memory");
    __syncthreads();
    if (threadIdx.x == 0) {
        unsigned* bar = b.bar;
        __builtin_amdgcn_s_waitcnt(0);
        unsigned nloc = b.st[0], nx = b.st[1];
        if (nloc == 0u) { xcd_barrier_complete(bar, b.x, nloc, nx); b.st[0] = nloc; b.st[1] = nx; }
        const unsigned old = xb_add(&bar[XB_XSUB(b.x)], 1u);
        const unsigned gen = old / nloc;
        if (old + 1u == (gen + 1u) * nloc) {
            __builtin_amdgcn_fence(__ATOMIC_RELEASE, "agent");
            asm volatile("s_waitcnt vmcnt(0)" ::: "memory");
            const unsigned og = xb_add(&bar[XB_TOP], 1u);
            const unsigned tg = og / nx;
            if (og + 1u == (tg + 1u) * nx) xb_add(&bar[XB_TOPGEN], 1u);
            else XB_SPIN(xb_ld(&bar[XB_TOPGEN]) == tg, bar);
            __builtin_amdgcn_fence(__ATOMIC_ACQUIRE, "agent");
            xb_add(&bar[XB_XGEN(b.x)], 1u);
            asm volatile("s_waitcnt vmcnt(0)" ::: "memory");
        } else {
            XB_SPIN(xb_ld(&bar[XB_XGEN(b.x)]) == gen, bar);
            __builtin_amdgcn_fence(__ATOMIC_ACQUIRE, "agent");
            asm volatile("s_waitcnt vmcnt(0)" ::: "memory");
        }
    }
    __syncthreads();
}

struct Frame { LAS unsigned char* lds; gu32* ctl; int tid, lane, wave, G, bid; Ptrs p; };

template <bool INPROJ> __device__ __forceinline__ void p0_transpose_item(const float* W, int N  , h16* WT, LAS float* scr, int item, int lane) {
    constexpr int K = 1024; const int nblk = (INPROJ ? NPAD : 1024) / 32, kb = item / nblk, nb = item % nblk, k0 = 64 * kb, n0 = 32 * nb;
    const int nn = n0 + (lane & 31); const bool valid = nn < N;
    float wv[32];
#pragma unroll
    for (int i = 0; i < 32; ++i) { const int kk = 2 * i + (lane >> 5); wv[i] = valid ? *(const GAS float*)(W + (size_t)(k0 + kk) * N + nn) : 0.f; }
#pragma unroll
    for (int i = 0; i < 32; ++i) { const int kk = 2 * i + (lane >> 5); scr[kk * 33 + (lane & 31)] = wv[i]; }
    LDS_WAIT(); asm volatile("" ::: "memory");
    const int c = lane & 7;
#pragma unroll
    for (int j = 0; j < 4; ++j) { const int n = (lane >> 3) + 8 * j; const LAS float* s = scr + (8 * c) * 33 + n;
        u32x4 o; o.x = cvtpk_h(s[0 * 33], s[1 * 33]); o.y = cvtpk_h(s[2 * 33], s[3 * 33]); o.z = cvtpk_h(s[4 * 33], s[5 * 33]); o.w = cvtpk_h(s[6 * 33], s[7 * 33]);
        const int col = n0 + n, pn = col >> 8, ca = col & 255; const bool mapA = INPROJ && slab_is_mapA(col >> 6);
        const int row = pn * 256 + tile_pos_of_col(ca, mapA);
        *(GAS u32x4*)(WT + (size_t)row * K + k0 + 8 * c) = o; }
    LDS_WAIT(); asm volatile("" ::: "memory");
}
__device__ __forceinline__ void skinny_item(Frame& F, const LAS float* AL, LAS float* RED, const float* W, int ldw, int nvalid, int n0, const float* bias, float* out, int ldo) {
    const int lane = F.tid & 63, wv = F.tid >> 6, cq = lane & 15, kg = wv * 4 + (lane >> 4); const int n = n0 + 4 * cq; const bool valid = n < nvalid;
    f32x4 acc[17];
#pragma unroll
    for (int i = 0; i < 17; ++i) acc[i] = (f32x4){0.f, 0.f, 0.f, 0.f};
    const float* wp = W + (size_t)(kg * 32) * ldw + (valid ? n : 0);
#pragma unroll 1
    for (int k = 0; k < 32; k += 8) {
        f32x4 w[8];
#pragma unroll
        for (int j = 0; j < 8; ++j) w[j] = valid ? *(const GAS f32x4*)(wp + (size_t)(k + j) * ldw) : (f32x4){0.f, 0.f, 0.f, 0.f};
#pragma unroll
        for (int q = 0; q < 2; ++q)
#pragma unroll
            for (int i = 0; i < 17; ++i) { const f32x4 a = *(const LAS f32x4*)(AL + i * 1024 + kg * 32 + k + 4 * q); acc[i] += (w[4 * q] * a[0] + w[4 * q + 1] * a[1]) + (w[4 * q + 2] * a[2] + w[4 * q + 3] * a[3]); }
    }
#pragma unroll
    for (int i = 0; i < 17; ++i)
#pragma unroll
        for (int c = 0; c < 4; ++c) { float v = acc[i][c]; v += lx_xor(v, 16, lane); v += lx_xor(v, 32, lane); acc[i][c] = v; }
    if (lane < 16) {
#pragma unroll
        for (int i = 0; i < 17; ++i) *(LAS f32x4*)(RED + (wv * 17 + i) * 64 + 4 * cq) = acc[i]; }
    __syncthreads();
    for (int o = F.tid; o < 17 * 64; o += NTHREADS) { const int i = o >> 6, c2 = o & 63; float s = 0.f;
#pragma unroll
        for (int g = 0; g < 8; ++g) s += RED[(g * 17 + i) * 64 + c2];
        const int nn = n0 + c2; if (nn < ldo) out[(size_t)i * ldo + nn] = (nn < nvalid) ? s + (bias ? bias[nn] : 0.f) : 0.f; }
    __syncthreads();
}
__device__ __forceinline__ void p0ab(Frame& F) {
    const Ptrs& p = F.p; unsigned char* ws = p.ws;
    { LAS float* scr = (LAS float*)(F.lds + F.wave * 16384); const int gw = F.bid * NWAVES + F.wave, NGW = F.G * NWAVES;
      constexpr int I_IN = 16 * (NPAD / 32), I_OUT = 16 * 32, NIT = DEPTH * (I_IN + I_OUT);
      for (int it = gw; it < NIT; it += NGW) { const int l = it / (I_IN + I_OUT), r = it % (I_IN + I_OUT);
          if (r < I_IN) p0_transpose_item<true>(p.win + (size_t)l * D * DIN, DIN, (h16*)(ws + WS_WINT) + (size_t)l * NPAD * D, scr, r, F.lane);
          else p0_transpose_item<false>(p.wout + (size_t)l * D * D, D, (h16*)(ws + WS_WOT) + (size_t)l * D * D, scr, r - I_IN, F.lane); }
      const int gt = F.bid * NTHREADS + F.tid;
      for (int i = gt; i < DEPTH * 4 * 128 * 128 / 4; i += F.G * NTHREADS) { const f32x4 v = ((const f32x4*)p.wsp)[i]; u32x2 w; w.x = cvtpk_h(v[0], v[1]); w.y = cvtpk_h(v[2], v[3]); ((u32x2*)(ws + WS_WS16))[i] = w; }
      if (F.bid == 1 && F.tid < 64 * DEPTH) { const int l = F.tid >> 6, d = F.lane; float a = fabsf(p.gq[l * 64 + d]), b2 = fabsf(p.gk[l * 64 + d]);
#pragma unroll
          for (int o = 1; o < 64; o <<= 1) { a = fmaxf(a, lx_xor(a, o, d)); b2 = fmaxf(b2, lx_xor(b2, o, d)); }
          if (d == 0) ((float*)(ws + WS_ROPE))[2048 + l] = 8.f * 1.4426950408889634f * a * b2 - 15.f; }
      if (F.bid == 0) { float* rope = (float*)(ws + WS_ROPE); for (int i = F.tid; i < 1024; i += NTHREADS) { const int pos = i >> 4, fi = i & 15; const float freq = exp2f(-(float)fi * (13.287712379549449f / 16.f)); const float rev = (float)pos * freq * 0.15915494309189535f;
          const float fr_ = rev - floorf(rev); rope[i] = __builtin_amdgcn_cosf(fr_); rope[1024 + i] = __builtin_amdgcn_sinf(fr_); } }
    }
    __syncthreads();
    { LAS float* AL = (LAS float*)F.lds; LAS float* RED = AL + 17 * 1024; bool loaded = false;
      for (int it = F.bid; it < DEPTH * 48; it += F.G) {
          if (!loaded) { for (int i = F.tid; i < 17 * 1024; i += NTHREADS) { const int bb = i >> 10, k = i & 1023; const float v = bb < 16 ? p.c[bb * D + k] : p.cctx[k]; AL[i] = siluf(v); } __syncthreads(); loaded = true; }
          const int l = it / 48, nb = it % 48;
          skinny_item(F, AL, RED, p.wada + (size_t)l * D * 3072, 3072, 3072, nb * 64, p.bada + l * 3072, (float*)(ws + WS_MOD) + (size_t)l * 17 * 3072, 3072); }
    }
}
__device__ __forceinline__ void p0c(Frame& F) {
    const Ptrs& p = F.p; unsigned char* ws = p.ws; const float* MOD = (const float*)(ws + WS_MOD);
    { LAS float* AL = (LAS float*)F.lds; LAS float* RED = AL + 17 * 1024; int loaded = -1;
      for (int it = F.bid; it < DEPTH * 56; it += F.G) { const int l = it / 56, nb = it % 56;
          if (loaded != l) { __syncthreads(); for (int i = F.tid; i < 17 * 1024; i += NTHREADS) { const int bb = i >> 10, k = i & 1023; AL[i] = MOD[((size_t)l * 17 + bb) * 3072 + k]; } __syncthreads(); loaded = l; }
          skinny_item(F, AL, RED, p.win + (size_t)l * D * DIN, DIN, DIN, nb * 64, nullptr, (float*)(ws + WS_SHW) + (size_t)l * 17 * NPAD, NPAD); }
    }
    { float* AM = (float*)(ws + WS_AMOD); const int gt = F.bid * NTHREADS + F.tid;
      for (int i = gt; i < DEPTH * 17 * 1024; i += F.G * NTHREADS) { const int k = i & 1023, lb = i >> 10, l = lb / 17; AM[i] = p.gnorm[l * D + k] * (1.f + MOD[(size_t)lb * 3072 + 1024 + k]); } }
    { const int gw = F.bid * NWAVES + F.wave, NGW = F.G * NWAVES; h16* XS = (h16*)(ws + WS_XS); h16* X16 = (h16*)(ws + WS_X16); float* RQ = (float*)(ws + WS_ROWSQ);
      for (int r0 = gw; r0 < MROWS; r0 += 2 * NGW) {
          f32x4 xv[2][2][2]; int rr[2]; bool ok[2];
#pragma unroll
          for (int q = 0; q < 2; ++q) { rr[q] = r0 + q * NGW; ok[q] = rr[q] < MROWS; const int r = ok[q] ? rr[q] : gw; const float* xr = r < MLAT ? p.x + (size_t)r * D : p.ctx + (size_t)(r - MLAT) * D;
#pragma unroll
              for (int j = 0; j < 2; ++j) { const int k = j * 512 + F.lane * 8; xv[q][j][0] = *(const GAS f32x4*)(xr + k); xv[q][j][1] = *(const GAS f32x4*)(xr + k + 4); } }
#pragma unroll
          for (int q = 0; q < 2; ++q) { const int r = ok[q] ? rr[q] : gw; const int bb = r < MLAT ? (r >> 11) : 16; const float* mod = MOD + (size_t)bb * 3072 + 1024; float ss = 0.f;
#pragma unroll
              for (int j = 0; j < 2; ++j) { const int k = j * 512 + F.lane * 8; u32x4 wx, wy;
#pragma unroll
                  for (int hh = 0; hh < 2; ++hh) { const f32x4 v = xv[q][j][hh], g = *(const GAS f32x4*)(p.gnorm + k + 4 * hh), s1 = *(const GAS f32x4*)(mod + k + 4 * hh);
                      ss += (v[0] * v[0] + v[1] * v[1]) + (v[2] * v[2] + v[3] * v[3]); const f32x4 y = v * (g * (s1 + 1.f));
                      if (hh == 0) { wy.x = cvtpk_h(y[0], y[1]); wy.y = cvtpk_h(y[2], y[3]); wx.x = cvtpk_h(v[0], v[1]); wx.y = cvtpk_h(v[2], v[3]); } else { wy.z = cvtpk_h(y[0], y[1]); wy.w = cvtpk_h(y[2], y[3]); wx.z = cvtpk_h(v[0], v[1]); wx.w = cvtpk_h(v[2], v[3]); } }
                  if (ok[q]) { *(GAS u32x4*)(XS + (size_t)r * D + k) = wy; *(GAS u32x4*)(X16 + (size_t)r * D + k) = wx; } }
#pragma unroll
              for (int o = 1; o < 64; o <<= 1) ss += lx_xor(ss, o, F.lane);
              if (ok[q] && F.lane < 16) *(GAS float*)(RQ + (size_t)r * 16 + F.lane) = F.lane == 0 ? ss : 0.f; } }
    }
}
__device__ __forceinline__ void p_final(Frame& F) {
    const Ptrs& p = F.p; const float* RQ = (const float*)(p.ws + WS_ROWSQ); const h16* X16 = (const h16*)(p.ws + WS_X16); const int gw = F.bid * NWAVES + F.wave, NGW = F.G * NWAVES;
    f32x4 g0[2], g1[2];
#pragma unroll
    for (int j = 0; j < 2; ++j) { const int k = j * 512 + F.lane * 8; g0[j] = *(const GAS f32x4*)(p.gfinal + k); g1[j] = *(const GAS f32x4*)(p.gfinal + k + 4); }
    for (int r0 = gw; r0 < MLAT; r0 += 4 * NGW) {
        h16x8 xv[4][2]; float q[4];
#pragma unroll
        for (int t = 0; t < 4; ++t) { const int r = r0 + t * NGW < MLAT ? r0 + t * NGW : gw; q[t] = F.lane < 16 ? *(const GAS float*)(RQ + (size_t)r * 16 + F.lane) : 0.f;
#pragma unroll
            for (int j = 0; j < 2; ++j) xv[t][j] = *(const GAS h16x8*)(X16 + (size_t)r * D + j * 512 + F.lane * 8); }
#pragma unroll
        for (int t = 0; t < 4; ++t) { const int r = r0 + t * NGW; float qq = q[t];
#pragma unroll
            for (int o = 1; o < 16; o <<= 1) qq += lx_xor(qq, o, F.lane);
            const float rs = __builtin_amdgcn_rsqf(lx_get(qq, 0) * (1.f / 1024.f) + EPS);
            if (r < MLAT) { float* orow = p.out + (size_t)r * D;
#pragma unroll
                for (int j = 0; j < 2; ++j) { const int k = j * 512 + F.lane * 8; const h16x8 v = xv[t][j];
                    *(GAS f32x4*)(orow + k) = (f32x4){(float)v[0], (float)v[1], (float)v[2], (float)v[3]} * rs * g0[j]; *(GAS f32x4*)(orow + k + 4) = (f32x4){(float)v[4], (float)v[5], (float)v[6], (float)v[7]} * rs * g1[j]; } } }
    }
}
namespace attn_body {
typedef short s16x8 __attribute__((ext_vector_type(8)));
#define H8(x) __builtin_bit_cast(h16x8, (x))
constexpr int NW = 8, QBLK = 32, QB = QBLK * NW, KVBLK = 64;
constexpr int QP = 512, KP = 64, YP = 1024, ZP = 512;
__device__ __forceinline__ int crow(int r, int hi) { return (r & 3) + 8 * (r >> 2) + 4 * hi; }
#define SBAR() __builtin_amdgcn_sched_barrier(0)
constexpr int NSLOT = 3, SLOTB = 8192;
constexpr int LDS_K = 0, LDS_V = NSLOT * SLOTB, LDS_WS = 2 * NSLOT * SLOTB, LDS_OST = LDS_WS + NW * 64 * 4, ATT_LDS_BYTES = LDS_OST + NW * 4096;
__device__ __forceinline__ void glds16(const void* gsrc, unsigned lds_dst) { unsigned keep;
  asm volatile("s_mov_b32 %0, m0\n\ts_mov_b32 m0, %2\n\ts_nop 0\n\tglobal_load_lds_dwordx4 %1, off\n\ts_mov_b32 m0, %0" : "=&s"(keep) : "v"(gsrc), "s"(lds_dst) : "memory"); }
__device__ __forceinline__ float max3f(float a, float b, float c) { float r; asm("v_max3_f32 %0, %1, %2, %3" : "=v"(r) : "v"(a), "v"(b), "v"(c)); return r; }
__device__ __forceinline__ float max2f(float a, float b) { float r; asm("v_max_f32_e32 %0, %1, %2" : "=v"(r) : "v"(a), "v"(b)); return r; }
__device__ __forceinline__ float fadd_s(float a, float b) { float r; asm("v_add_f32_e32 %0, %1, %2" : "=v"(r) : "v"(a), "v"(b)); return r; }
__device__ __forceinline__ float fsub_s(float a, float b) { float r; asm("v_sub_f32_e32 %0, %1, %2" : "=v"(r) : "v"(a), "v"(b)); return r; }
#define WAIT_BAR(N) asm volatile("s_waitcnt vmcnt(" #N ") lgkmcnt(0)\n\ts_barrier" ::: "memory")
__device__ __forceinline__ void qkt(f32x16& p0, f32x16& p1, const char* Kslot, const s16x8* qr, const f32x16& negm, int r32, int hi) {
  const char* kb = Kslot + hi * 1024 + r32 * 16;
#pragma unroll
  for (int d0 = 0; d0 < 4; ++d0) {
    const s16x8 b0 = *reinterpret_cast<const s16x8*>(kb + d0 * 2048);
    const s16x8 b1 = *reinterpret_cast<const s16x8*>(kb + d0 * 2048 + 512);
    if (d0 == 0) { p0 = __builtin_amdgcn_mfma_f32_32x32x16_f16(H8(b0), H8(qr[0]), negm, 0, 0, 0); p1 = __builtin_amdgcn_mfma_f32_32x32x16_f16(H8(b1), H8(qr[0]), negm, 0, 0, 0); }
    else { p0 = __builtin_amdgcn_mfma_f32_32x32x16_f16(H8(b0), H8(qr[d0]), p0, 0, 0, 0); p1 = __builtin_amdgcn_mfma_f32_32x32x16_f16(H8(b1), H8(qr[d0]), p1, 0, 0, 0); } }
}
typedef LAS const char* lds_cptr;
__device__ __forceinline__ void kload8(s16x8* kf, lds_cptr kp) {
  kf[0] = *(const LAS s16x8*)(kp);        kf[1] = *(const LAS s16x8*)(kp + 512);
  kf[2] = *(const LAS s16x8*)(kp + 2048); kf[3] = *(const LAS s16x8*)(kp + 2560);
  kf[4] = *(const LAS s16x8*)(kp + 4096); kf[5] = *(const LAS s16x8*)(kp + 4608);
  kf[6] = *(const LAS s16x8*)(kp + 6144); kf[7] = *(const LAS s16x8*)(kp + 6656);
}
__device__ __forceinline__ void kload2(s16x8* kf, lds_cptr kp, int j) { kf[2 * j] = *(const LAS s16x8*)(kp + j * 2048); kf[2 * j + 1] = *(const LAS s16x8*)(kp + j * 2048 + 512); }
__device__ __forceinline__ s16x4 vtr(lds_cptr p) { return __builtin_bit_cast(s16x4, __builtin_amdgcn_ds_read_tr16_b64_v4i16((LAS v4i16_t*)p)); }
__device__ __forceinline__ float rowmax(const f32x16& p0, const f32x16& p1) {
  float a = max3f(p0[0], p0[1], p1[0]), b = max3f(p0[2], p0[3], p1[1]); a = max3f(a, p1[2], p1[3]);
#pragma unroll
  for (int r = 4; r < 16; r += 4) { a = max3f(a, p0[r], p0[r + 1]); b = max3f(b, p0[r + 2], p0[r + 3]); a = max3f(a, p1[r], p1[r + 1]); b = max3f(b, p1[r + 2], p1[r + 3]); }
  const float m = max2f(a, b);
  auto rr = __builtin_amdgcn_permlane32_swap(__float_as_uint(m), __float_as_uint(m), false, false);
  return max2f(__uint_as_float(rr[0]), __uint_as_float(rr[1]));
}
__device__ __forceinline__ void pv(f32x16* o, int vb, s16x8 pa0, s16x8 pa1, s16x8 pa2, s16x8 pa3) {
#pragma unroll
  for (int d0 = 0; d0 < 2; ++d0) { s16x4 lo[4], hi[4];
#pragma unroll
    for (int ks = 0; ks < 4; ++ks) {
      asm volatile("ds_read_b64_tr_b16 %0,%1 offset:%c2" : "=&v"(lo[ks]) : "v"(vb), "i"(d0 * 4096 + ks * 1024) : "memory");
      asm volatile("ds_read_b64_tr_b16 %0,%1 offset:%c2" : "=&v"(hi[ks]) : "v"(vb), "i"(d0 * 4096 + ks * 1024 + 512) : "memory"); }
    asm volatile("s_waitcnt lgkmcnt(0)" ::: "memory"); SBAR();
#define PK(k) (s16x8){lo[k][0], lo[k][1], lo[k][2], lo[k][3], hi[k][0], hi[k][1], hi[k][2], hi[k][3]}
    o[d0] = __builtin_amdgcn_mfma_f32_32x32x16_f16(H8(pa0), H8(PK(0)), o[d0], 0, 0, 0);
    o[d0] = __builtin_amdgcn_mfma_f32_32x32x16_f16(H8(pa1), H8(PK(1)), o[d0], 0, 0, 0);
    o[d0] = __builtin_amdgcn_mfma_f32_32x32x16_f16(H8(pa2), H8(PK(2)), o[d0], 0, 0, 0);
    o[d0] = __builtin_amdgcn_mfma_f32_32x32x16_f16(H8(pa3), H8(PK(3)), o[d0], 0, 0, 0);
#undef PK
  }
}
template <int THRL, bool FIXM> __device__ __forceinline__ void attn_unit(const h16* Qrows, const h16* __restrict__ Kh, const h16* __restrict__ Vh, const int NT, h16* Yrows, const h16* BZrows, char* shm, const int tid, const float mfix) {
  const int lane = tid & 63, r32 = lane & 31, hi = lane >> 5; const int wid = __builtin_amdgcn_readfirstlane(tid >> 6);
  const h16* Qw = Qrows + (long)(wid * QBLK) * QP;
  const unsigned lds0 = (unsigned)(uintptr_t)shm;
  float* wsf = (float*)(shm + LDS_WS) + wid * 64;
  const h16* ksrc = Kh + (long)lane * KP + wid * 8;
  const h16* vsrc = Vh + (long)(16 * (wid & 3) + (lane >> 2)) * KP + (wid >> 2) * 32 + (lane & 3) * 8;
  const unsigned kdst = lds0 + LDS_K + wid * 1024, vdst = lds0 + LDS_V + wid * 1024;
#define DMA_K(t, slot) glds16(ksrc + (long)(t) * KVBLK * KP, (unsigned)__builtin_amdgcn_readfirstlane(kdst + (slot)))
#define DMA_V(t, slot) glds16(vsrc + (long)(t) * KVBLK * KP, (unsigned)__builtin_amdgcn_readfirstlane(vdst + (slot)))
  const int vb0 = (int)(lds0 + LDS_V) + ((lane >> 4) & 1) * 32 + (lane & 3) * 8 + (4 * hi + ((lane & 15) >> 2)) * 64;
  const char* Kbase = shm + LDS_K; s16x8 kf[8];
  const lds_cptr shm3 = (lds_cptr)shm; const lds_cptr kp0 = shm3 + LDS_K + hi * 1024 + r32 * 16; const lds_cptr vp0 = shm3 + LDS_V + ((lane >> 4) & 1) * 32 + (lane & 3) * 8 + (4 * hi + ((lane & 15) >> 2)) * 64;
  DMA_K(0, 0); DMA_V(0, 0); DMA_K(1, SLOTB);
  s16x8 qr[4];
#pragma unroll
  for (int d0 = 0; d0 < 4; ++d0) qr[d0] = *(const GAS s16x8*)(Qw + (long)r32 * QP + d0 * 16 + hi * 8);
  float mhat = 0.f, l_reg = 0.f; f32x16 o[2]; o[0] = f32x16{}; o[1] = f32x16{}; f32x16 negm = f32x16{}; asm volatile("" : "+v"(negm));
  bool resc = false;
#define START(P0, P1) do { const float rm = FIXM ? mfix : rowmax(P0, P1); resc = false; \
    { const float dl = rm; mhat = fadd_s(mhat, dl); \
      _Pragma("unroll") for (int r = 0; r < 16; ++r) { P0[r] = fsub_s(P0[r], dl); P1[r] = fsub_s(P1[r], dl); } \
      _Pragma("unroll") for (int r = 0; r < 16; ++r) negm[r] = -mhat; asm volatile("" : "+v"(negm)); } \
    _Pragma("unroll") for (int r = 0; r < 16; ++r) P0[r] = __builtin_amdgcn_exp2f(P0[r]); } while (0)
#define RESC() do { if (!FIXM && resc) { asm volatile("s_waitcnt lgkmcnt(0)" ::: "memory"); \
      _Pragma("unroll") for (int d_ = 0; d_ < 2; ++d_) _Pragma("unroll") for (int r = 0; r < 16; ++r) o[d_][r] *= wsf[crow(r, hi)]; } } while (0)
  f32x16 pA0, pA1, pB0, pB1;
  int sl_prev = 0, sl_cur = 0, sl_next = SLOTB;
#define ROT() do { sl_prev = sl_cur; sl_cur = sl_next; sl_next = (sl_next == (NSLOT - 1) * SLOTB) ? 0 : sl_next + SLOTB; } while (0)
  DMA_K(2, 2 * SLOTB);
  WAIT_BAR(3);
  qkt(pA0, pA1, Kbase, qr, negm, r32, hi); asm volatile("s_nop 15\n\ts_nop 7" : "+v"(pA0), "+v"(pA1));
  START(pA0, pA1);
  _Pragma("unroll") for (int r = 0; r < 16; ++r) pA1[r] = __builtin_amdgcn_exp2f(pA1[r]);
  WAIT_BAR(0);
  DMA_K(3, 0); DMA_V(1, SLOTB);
  ROT();
  kload8(kf, kp0 + sl_cur);
  WAIT_BAR(2);
  s16x4 vlo[8], vhi[8]; u32x4 pw0, pw1, pw2, pw3;
#define PKW(P, B) cvtpk_h(P[B], P[B + 1])
#define PAF(k) __builtin_bit_cast(h16x8, pw##k)
#define VFR(i) H8(((s16x8){vlo[i][0], vlo[i][1], vlo[i][2], vlo[i][3], vhi[i][0], vhi[i][1], vhi[i][2], vhi[i][3]}))
#define PIN(x) asm volatile("" : "+v"(x))
#define MX3(a, b, c) __builtin_fmaxf(__builtin_fmaxf((a), (b)), (c))
#define GAPA(MF, A0, A1, A2, A3, W0, W1, PW) do { MF; sacc += A0; sacc += A1; sacc += A2; sacc += A3; PIN(sacc); W0; W1; PIN(PW); SBAR(); } while (0)
#define EX(v) __builtin_amdgcn_exp2f(v)
#define GAPB(MF, X, B) do { MF; X[B] = EX(X[B]); X[B + 1] = EX(X[B + 1]); X[B + 2] = EX(X[B + 2]); X[B + 3] = EX(X[B + 3]); PIN(X); SBAR(); } while (0)
#define VRD(i) do { vlo[i] = vtr(vp_ + (((i) >> 2) * 4096 + ((i) & 3) * 1024)); vhi[i] = vtr(vp_ + (((i) >> 2) * 4096 + ((i) & 3) * 1024 + 512)); } while (0)
#define KRD(G, j) do { if (G) { kload2(kf, kp0 + sl_next, j); SBAR(); } } while (0)
#define QK(kfi, qri, C) __builtin_amdgcn_mfma_f32_32x32x16_f16(H8(kf[kfi]), H8(qr[qri]), C, 0, 0, 0)
#define STEP(C0, C1, P0, P1, t, GK, GV, GL) do { SBAR(); \
    const lds_cptr vp_ = vp0 + sl_prev; \
    VRD(0); SBAR(); float sacc = (P0[0] + P0[1]); \
    GAPA(C0 = QK(0, 0, negm), P0[2], P0[3], P0[4], P0[5],     pw0[0] = PKW(P0, 0), pw0[1] = PKW(P0, 2), pw0); \
    VRD(4); SBAR(); GAPA(C1 = QK(1, 0, negm), P0[6], P0[7], P0[8], P0[9],     pw0[2] = PKW(P0, 4), pw0[3] = PKW(P0, 6), pw0); \
    VRD(1); SBAR(); GAPA(C0 = QK(2, 1, C0),   P0[10], P0[11], P0[12], P0[13], pw1[0] = PKW(P0, 8), pw1[1] = PKW(P0, 10), pw1); \
    VRD(5); SBAR(); GAPA(C1 = QK(3, 1, C1),   P0[14], P0[15], P1[0], P1[1],   pw1[2] = PKW(P0, 12), pw1[3] = PKW(P0, 14), pw1); \
    VRD(2); SBAR(); GAPA(C0 = QK(4, 2, C0),   P1[2], P1[3], P1[4], P1[5],     pw2[0] = PKW(P1, 0), pw2[1] = PKW(P1, 2), pw2); \
    VRD(6); SBAR(); GAPA(C1 = QK(5, 2, C1),   P1[6], P1[7], P1[8], P1[9],     pw2[2] = PKW(P1, 4), pw2[3] = PKW(P1, 6), pw2); \
    VRD(3); SBAR(); GAPA(C0 = QK(6, 3, C0),   P1[10], P1[11], P1[12], P1[13], pw3[0] = PKW(P1, 8), pw3[1] = PKW(P1, 10), pw3); \
    VRD(7); SBAR(); GAPA(C1 = QK(7, 3, C1),   P1[14], P1[15], 0.f, 0.f,       pw3[2] = PKW(P1, 12), pw3[3] = PKW(P1, 14), pw3); \
    l_reg += sacc; \
    if (GK) { DMA_K((t) + 3, sl_cur); } if (GV) { DMA_V((t) + 1, sl_next); } \
    if (!FIXM) { float a = MX3(C0[0], C0[1], C1[0]), b = MX3(C0[2], C0[3], C1[1]); a = MX3(a, C1[2], C1[3]); \
      _Pragma("unroll") for (int r = 4; r < 16; r += 4) { a = MX3(a, C0[r], C0[r + 1]); b = MX3(b, C0[r + 2], C0[r + 3]); a = MX3(a, C1[r], C1[r + 1]); b = MX3(b, C1[r + 2], C1[r + 3]); } \
      float rm = __builtin_fmaxf(a, b); { auto rr = __builtin_amdgcn_permlane32_swap(__float_as_uint(rm), __float_as_uint(rm), false, false); rm = __builtin_fmaxf(__uint_as_float(rr[0]), __uint_as_float(rr[1])); } \
      resc = false; \
      if (__builtin_expect(__any(rm > (float)THRL), 0)) { const float dl = __builtin_fmaxf(rm, 0.f); mhat += dl; \
        _Pragma("unroll") for (int r = 0; r < 16; ++r) { C0[r] -= dl; C1[r] -= dl; } \
        _Pragma("unroll") for (int r = 0; r < 16; ++r) negm[r] = -mhat; asm volatile("" : "+v"(negm)); \
        const float f = __builtin_amdgcn_exp2f(-dl); l_reg *= f; if (hi == 0) wsf[r32] = f; resc = true; } } \
    SBAR(); \
    GAPB(o[0] = __builtin_amdgcn_mfma_f32_32x32x16_f16(PAF(0), VFR(0), o[0], 0, 0, 0), C0, 0); \
    GAPB(o[1] = __builtin_amdgcn_mfma_f32_32x32x16_f16(PAF(0), VFR(4), o[1], 0, 0, 0), C0, 4); \
    KRD(GL, 0); GAPB(o[0] = __builtin_amdgcn_mfma_f32_32x32x16_f16(PAF(1), VFR(1), o[0], 0, 0, 0), C0, 8); \
    KRD(GL, 1); GAPB(o[1] = __builtin_amdgcn_mfma_f32_32x32x16_f16(PAF(1), VFR(5), o[1], 0, 0, 0), C0, 12); \
    KRD(GL, 2); GAPB(o[0] = __builtin_amdgcn_mfma_f32_32x32x16_f16(PAF(2), VFR(2), o[0], 0, 0, 0), C1, 0); \
    KRD(GL, 3); GAPB(o[1] = __builtin_amdgcn_mfma_f32_32x32x16_f16(PAF(2), VFR(6), o[1], 0, 0, 0), C1, 4); \
    GAPB(o[0] = __builtin_amdgcn_mfma_f32_32x32x16_f16(PAF(3), VFR(3), o[0], 0, 0, 0), C1, 8); \
    GAPB(o[1] = __builtin_amdgcn_mfma_f32_32x32x16_f16(PAF(3), VFR(7), o[1], 0, 0, 0), C1, 12); \
    } while (0)
  int t = 1;
  for (; t + 5 < NT; t += 2) {
    STEP(pB0, pB1, pA0, pA1, t, true, true, true);     WAIT_BAR(2); RESC(); ROT();
    STEP(pA0, pA1, pB0, pB1, t + 1, true, true, true); WAIT_BAR(2); RESC(); ROT();
  }
#define ENDW(tt) do { if ((tt) + 3 < NT) { WAIT_BAR(2); } else if ((tt) + 2 < NT) { WAIT_BAR(1); } else { WAIT_BAR(0); } } while (0)
  for (; t + 1 < NT; t += 2) {
    STEP(pB0, pB1, pA0, pA1, t, (t + 3 < NT), (t + 1 < NT), (t + 1 < NT));         ENDW(t);     RESC(); ROT();
    STEP(pA0, pA1, pB0, pB1, t + 1, (t + 4 < NT), (t + 2 < NT), (t + 2 < NT));     ENDW(t + 1); RESC(); ROT();
  }
  STEP(pB0, pB1, pA0, pA1, NT - 1, false, false, false); RESC();
  { float sacc = pB0[0] + pB0[1]; _Pragma("unroll") for (int r = 2; r < 16; ++r) sacc += pB0[r]; _Pragma("unroll") for (int r = 0; r < 16; ++r) sacc += pB1[r]; l_reg += sacc;
    pw0 = (u32x4){PKW(pB0, 0), PKW(pB0, 2), PKW(pB0, 4), PKW(pB0, 6)}; pw1 = (u32x4){PKW(pB0, 8), PKW(pB0, 10), PKW(pB0, 12), PKW(pB0, 14)}; pw2 = (u32x4){PKW(pB1, 0), PKW(pB1, 2), PKW(pB1, 4), PKW(pB1, 6)}; pw3 = (u32x4){PKW(pB1, 8), PKW(pB1, 10), PKW(pB1, 12), PKW(pB1, 14)};
    SBAR(); pv(o, vb0 + sl_cur, __builtin_bit_cast(s16x8, pw0), __builtin_bit_cast(s16x8, pw1), __builtin_bit_cast(s16x8, pw2), __builtin_bit_cast(s16x8, pw3)); }
  h16x8 zg[4];
  { const h16* Zw0 = BZrows + (long)(wid * QBLK) * ZP;
#pragma unroll
    for (int i = 0; i < 4; ++i) zg[i] = *(const GAS h16x8*)(Zw0 + (long)(i * 8 + (lane >> 3)) * ZP + (lane & 7) * 8); }
#undef PKW
#undef PAF
#undef VFR
#undef PIN
#undef MX3
#undef GAPA
#undef GAPB
#undef EX
#undef VRD
#undef KRD
#undef QK
#undef STEP
#undef ENDW
  { auto rr = __builtin_amdgcn_permlane32_swap(__float_as_uint(l_reg), __float_as_uint(l_reg), false, false); l_reg = __uint_as_float(rr[0]) + __uint_as_float(rr[1]); }
  if (hi == 0) wsf[32 + r32] = l_reg; asm volatile("s_waitcnt lgkmcnt(0)" ::: "memory");
  float rli[16];
#pragma unroll
  for (int r = 0; r < 16; ++r) rli[r] = __builtin_amdgcn_rcpf(wsf[32 + crow(r, hi)]);
  h16* Yw = Yrows + (long)(wid * QBLK) * YP;
  { h16* stg = (h16*)(shm + LDS_OST) + wid * 2048;
#pragma unroll
    for (int r = 0; r < 16; ++r) { const int orow = crow(r, hi);
#pragma unroll
      for (int d0 = 0; d0 < 2; ++d0) stg[orow * 64 + d0 * 32 + r32] = (h16)(o[d0][r] * rli[r]); }
    asm volatile("s_waitcnt lgkmcnt(0)" ::: "memory");
#pragma unroll
    for (int i = 0; i < 4; ++i) { const int row = i * 8 + (lane >> 3), ch = lane & 7; const h16x8 v = *(const h16x8*)(stg + row * 64 + ch * 8); const h16x8 z = zg[i];
      u32x4 w; w.x = cvtpk_h((float)v[0] * siluf((float)z[0]), (float)v[1] * siluf((float)z[1])); w.y = cvtpk_h((float)v[2] * siluf((float)z[2]), (float)v[3] * siluf((float)z[3]));
      w.z = cvtpk_h((float)v[4] * siluf((float)z[4]), (float)v[5] * siluf((float)z[5])); w.w = cvtpk_h((float)v[6] * siluf((float)z[6]), (float)v[7] * siluf((float)z[7]));
      *(GAS u32x4*)(Yw + (long)row * YP + ch * 8) = w; } }
  asm volatile("s_waitcnt lgkmcnt(0)\n\ts_barrier" ::: "memory");
#undef DMA_K
#undef DMA_V
#undef START
#undef RESC
#undef ROT
}
#undef SBAR
#undef WAIT_BAR
}

namespace mx {
using attn_body::s16x8; using attn_body::crow;
#define H8(x) __builtin_bit_cast(h16x8, (x))
constexpr float LOG2E = 1.4426950408889634f;
__device__ __forceinline__ s16x8 tr_frag(LAS const char* img, int half_bytes, int nb, int ks, int lane) {
    LAS const char* p = img + nb * half_bytes + (16 * ks + 8 * (lane >> 5) + ((lane & 15) >> 2)) * 64 + (16 * ((lane >> 4) & 1) + 4 * (lane & 3)) * 2;
    const s16x4 lo = __builtin_bit_cast(s16x4, __builtin_amdgcn_ds_read_tr16_b64_v4i16((LAS v4i16_t*)p));
    const s16x4 hi = __builtin_bit_cast(s16x4, __builtin_amdgcn_ds_read_tr16_b64_v4i16((LAS v4i16_t*)(p + 256)));
    return (s16x8){lo[0], lo[1], lo[2], lo[3], hi[0], hi[1], hi[2], hi[3]};
}
__device__ __forceinline__ float wave_incl_sum(float v, int lane) {
    (void)lane;
    v += dpp_f<0x111>(0.f, v); v += dpp_f<0x112>(0.f, v); v += dpp_f<0x114>(0.f, v); v += dpp_f<0x118>(0.f, v);
    v += dpp_f<0x142, 0xA>(0.f, v); v += dpp_f<0x143, 0xC>(0.f, v);
    return v;
}
__device__ __forceinline__ float wave_incl_max(float v, int lane) {
    (void)lane; const float ninf = -INFINITY;
    v = fmaxf(v, dpp_f<0x111>(ninf, v)); v = fmaxf(v, dpp_f<0x112>(ninf, v)); v = fmaxf(v, dpp_f<0x114>(ninf, v)); v = fmaxf(v, dpp_f<0x118>(ninf, v));
    v = fmaxf(v, dpp_f<0x142, 0xA>(ninf, v)); v = fmaxf(v, dpp_f<0x143, 0xC>(ninf, v));
    return v;
}
struct GateRaw { float li0, lf0, li1, lf1; };
__device__ __forceinline__ GateRaw gate_load(const float* G, size_t rb, int h, int dir, int lane) {
    const int p0 = 2 * lane, t0 = dir ? 127 - p0 : p0, t1 = dir ? t0 - 1 : t0 + 1; GateRaw r;
    r.li0 = *(const GAS float*)(G + (rb + t0) * 16 + dir * 8 + h); r.lf0 = *(const GAS float*)(G + (rb + t0) * 16 + dir * 8 + 4 + h);
    r.li1 = *(const GAS float*)(G + (rb + t1) * 16 + dir * 8 + h); r.lf1 = *(const GAS float*)(G + (rb + t1) * 16 + dir * 8 + 4 + h);
    return r;
}
__device__ __forceinline__ void gate_compute(const GateRaw& r, int dir, float m0, LAS float* bL, LAS float* gL, LAS float* ML, int lane, float& Gmax, float& bend) {
    const int p0 = 2 * lane, t0 = dir ? 127 - p0 : p0, t1 = dir ? t0 - 1 : t0 + 1;
    const float incl = wave_incl_sum(r.lf0 + r.lf1, lane), excl = incl - (r.lf0 + r.lf1);
    const float b0 = excl + r.lf0, b1 = incl, g0 = r.li0 - b0, g1 = r.li1 - b1;
    const float gi = wave_incl_max(fmaxf(g0, g1), lane); const float ge = dpp_f<0x138>(-INFINITY, gi);
    const float G0 = fmaxf(ge, g0), G1 = gi;
    bL[t0] = b0; bL[t1] = b1; gL[t0] = g0; gL[t1] = g1; ML[t0] = fmaxf(m0, G0); ML[t1] = fmaxf(m0, G1);
    Gmax = lx_get(gi, 63); bend = lx_get(incl, 63);
}
__device__ __forceinline__ void gate_scan(const float* G, size_t rb, int h, int dir, float m0, LAS float* bL, LAS float* gL, LAS float* ML, int lane, float& Gmax, float& bend) {
    const GateRaw r = gate_load(G, rb, h, dir, lane); gate_compute(r, dir, m0, bL, gL, ML, lane, Gmax, bend);
}

constexpr int GM_SCR = 65536;
__device__ __forceinline__ void gmlp_unit(unsigned char* ws, h16* Y, const h16* Ws16  , const float* bs  , size_t r0, LAS unsigned char* lds, int tid) {
    const int lane = tid & 63, wid = __builtin_amdgcn_readfirstlane(tid >> 6), r32 = lane & 31, hi = lane >> 5;
    const h16* VN = (const h16*)(ws + WS_VN); const h16* GU = (const h16*)(ws + WS_GU); const h16* SZ = (const h16*)(ws + WS_SZ);
    const int g = wid >> 1, ph = wid & 1; const h16* Wg = Ws16 + (size_t)g * 128 * 128;
    u32x4 stg[8];
#pragma unroll
    for (int j = 0; j < 8; ++j) { const int i = tid + 512 * j, row = i >> 5, c8 = i & 31; stg[j] = *(const GAS u32x4*)(VN + (r0 + row) * 256 + c8 * 8); }
    s16x8 af[2][8];
#pragma unroll
    for (int q = 0; q < 2; ++q)
#pragma unroll
        for (int ks = 0; ks < 8; ++ks) af[q][ks] = *(const GAS s16x8*)(Wg + (size_t)(32 * (2 * ph + q) + r32) * 128 + 16 * ks + 8 * hi);
    const int erow = lane >> 1, ecol = (lane & 1) * 16;
    h16x8 gu[2][2][2], sz[2][2][2]; float bias[2];
#pragma unroll
    for (int q = 0; q < 2; ++q) { bias[q] = *(const GAS float*)(bs + g * 128 + 32 * (2 * ph + q) + erow);
#pragma unroll
        for (int db = 0; db < 2; ++db) { const size_t go = (r0 + 32 * (2 * ph + q) + erow) * 256 + g * 64 + 32 * db + ecol;
            gu[q][db][0] = *(const GAS h16x8*)(GU + go); gu[q][db][1] = *(const GAS h16x8*)(GU + go + 8); sz[q][db][0] = *(const GAS h16x8*)(SZ + go); sz[q][db][1] = *(const GAS h16x8*)(SZ + go + 8); } }
#pragma unroll
    for (int j = 0; j < 8; ++j) { const int i = tid + 512 * j, row = i >> 5, c8 = i & 31, gg = c8 >> 3, cg = (c8 & 7) * 8;
        const h16x8 hv = __builtin_bit_cast(h16x8, stg[j]); float x[8]; float sm = 0.f;
#pragma unroll
        for (int k = 0; k < 8; ++k) { x[k] = geluf((float)hv[k]); sm += x[k]; }
        sm = oct_sum(sm);
        const float mu = sm * (1.f / 64.f); float q = 0.f;
#pragma unroll
        for (int k = 0; k < 8; ++k) { x[k] -= mu; q += x[k] * x[k]; }
        q = oct_sum(q);
        const float rd = __builtin_amdgcn_rsqf(q * (1.f / 64.f) + EPS);
        u32x4 o; o.x = cvtpk_h(x[0] * rd, x[1] * rd); o.y = cvtpk_h(x[2] * rd, x[3] * rd); o.z = cvtpk_h(x[4] * rd, x[5] * rd); o.w = cvtpk_h(x[6] * rd, x[7] * rd);
        *(LAS u32x4*)(lds + gg * 16384 + (cg >> 5) * 8192 + row * 64 + (cg & 31) * 2) = o; }
    BAR_LDS();
    LAS float* scr = (LAS float*)(lds + GM_SCR) + wid * (32 * 36);
#pragma unroll
    for (int db = 0; db < 2; ++db) {
        s16x8 bf[8];
#pragma unroll
        for (int ks = 0; ks < 8; ++ks) bf[ks] = tr_frag((LAS const char*)lds + g * 16384, 8192, db, ks, lane);
#pragma unroll
        for (int q = 0; q < 2; ++q) {
            f32x16 acc = f32x16{};
#pragma unroll
            for (int ks = 0; ks < 8; ++ks) acc = __builtin_amdgcn_mfma_f32_32x32x16_f16(H8(af[q][ks]), H8(bf[ks]), acc, 0, 0, 0);
#pragma unroll
            for (int r = 0; r < 16; ++r) scr[crow(r, hi) * 36 + r32] = acc[r];
            LDS_WAIT();
            float sv[16];
#pragma unroll
            for (int v4 = 0; v4 < 4; ++v4) { const f32x4 v = *(const LAS f32x4*)(scr + erow * 36 + ecol + 4 * v4); sv[4 * v4] = v[0]; sv[4 * v4 + 1] = v[1]; sv[4 * v4 + 2] = v[2]; sv[4 * v4 + 3] = v[3]; }
            LDS_WAIT();
            float y[16];
#pragma unroll
            for (int k = 0; k < 8; ++k) { y[k] = geluf((float)gu[q][db][0][k]) * (sv[k] + bias[q]) * siluf((float)sz[q][db][0][k]); y[8 + k] = geluf((float)gu[q][db][1][k]) * (sv[8 + k] + bias[q]) * siluf((float)sz[q][db][1][k]); }
            u32x4 w0, w1; w0.x = cvtpk_h(y[0], y[1]); w0.y = cvtpk_h(y[2], y[3]); w0.z = cvtpk_h(y[4], y[5]); w0.w = cvtpk_h(y[6], y[7]); w1.x = cvtpk_h(y[8], y[9]); w1.y = cvtpk_h(y[10], y[11]); w1.z = cvtpk_h(y[12], y[13]); w1.w = cvtpk_h(y[14], y[15]);
            h16* yp = Y + (r0 + 32 * (2 * ph + q) + erow) * D + g * 64 + 32 * db + ecol; *(GAS u32x4*)yp = w0; *(GAS u32x4*)(yp + 8) = w1;
        }
    }
    BAR_LDS();
}

constexpr int SC_V = 0, SC_K = 32768, SC_WK = 65536, SC_GM = SC_WK + 18 * 512, SC_BE = SC_GM + 128, SC_TMP = SC_BE + 128, SC_CST = SC_TMP + 8 * 1536;
__device__ __forceinline__ size_t chunk_row0(int b, int dir, int ci) {
    if (ci < 2) return (size_t)MLAT + (size_t)b * CTXL + 128 * (dir ? 1 - ci : ci);
    return (size_t)b * SEQ + 128 * (dir ? 15 - (ci - 2) : ci - 2);
}
__device__ __forceinline__ unsigned char* state_ptr(unsigned char* ws, int b, int h, int dir, int ci) { return ws + WS_ST + (size_t)(((b * 4 + h) * 2 + dir) * NCHUNK + ci) * ST_STRIDE; }
__device__ __forceinline__ void scan_unit(unsigned char* ws, int b, int h, int dir, gu32* flag, LAS unsigned char* lds, int tid) {
    const int lane = tid & 63, wid = __builtin_amdgcn_readfirstlane(tid >> 6), r32 = lane & 31, hi = lane >> 5;
    const h16* CK = (const h16*)(ws + WS_CK); const h16* CV = (const h16*)(ws + WS_CV); const float* G = (const float*)(ws + WS_G);
    LAS float* WKA = (LAS float*)(lds + SC_WK); LAS float* GMA = (LAS float*)(lds + SC_GM); LAS float* BEA = (LAS float*)(lds + SC_BE);
    const int srow = tid >> 3, sc8 = tid & 7; const int soff = (sc8 >> 2) * 8192 + srow * 64 + (sc8 & 3) * 16;
    const size_t lofs = (size_t)srow * 256 + h * 64 + sc8 * 8;
    u32x4 kA[2], vA[2], kB[2], vB[2], kC[2], vC[2], kD[2], vD[2];
#define SC_LOAD(KR, VR, ci_) do { if ((ci_) < NCHUNK) { const size_t rb_ = chunk_row0(b, dir, (ci_)); _Pragma("unroll") for (int j = 0; j < 2; ++j) { \
        KR[j] = *(const GAS u32x4*)(CK + (rb_ + 64 * j) * 256 + lofs); VR[j] = *(const GAS u32x4*)(CV + (rb_ + 64 * j) * 256 + lofs); } } } while (0)
    SC_LOAD(kA, vA, 0); SC_LOAD(kB, vB, 1); SC_LOAD(kC, vC, 2); SC_LOAD(kD, vD, 3);
    { LAS float* tmpb = (LAS float*)(lds + SC_TMP) + wid * 384;
      GateRaw gr[3];
#pragma unroll
      for (int q = 0; q < 3; ++q) { const int ci = wid + 8 * q; gr[q] = GateRaw{0.f, 0.f, 0.f, 0.f}; if (ci < NCHUNK) gr[q] = gate_load(G, chunk_row0(b, dir, ci), h, dir, lane); }
#pragma unroll
      for (int q = 0; q < 3; ++q) { const int ci = wid + 8 * q; if (ci < NCHUNK) { float Gmax, bend; gate_compute(gr[q], dir, 0.f, tmpb, tmpb + 128, tmpb + 256, lane, Gmax, bend);
          LDS_WAIT();
          WKA[ci * 128 + lane] = __builtin_amdgcn_exp2f((tmpb[128 + lane] - Gmax) * LOG2E); WKA[ci * 128 + lane + 64] = __builtin_amdgcn_exp2f((tmpb[128 + lane + 64] - Gmax) * LOG2E);
          if (lane == 0) { GMA[ci] = Gmax; BEA[ci] = bend; } LDS_WAIT(); } } }
    BAR_LDS();
    f32x16 Cacc = f32x16{}; float nacc = 0.f; float m = 0.f;
    const int dblk = (wid >> 1) & 1, eblk = wid & 1;
#define SC_BODY(KR, VR, ci_) do { const int ci = (ci_); if (ci < NCHUNK) { \
        unsigned char* st = state_ptr(ws, b, h, dir, ci); const int buf = (ci & 1) * 16384; \
        _Pragma("unroll") for (int j = 0; j < 2; ++j) { *(LAS u32x4*)(lds + SC_V + buf + soff + j * 4096) = VR[j]; \
            const float w = WKA[ci * 128 + srow + 64 * j]; const h16x8 kv = __builtin_bit_cast(h16x8, KR[j]); u32x4 o; \
            o.x = cvtpk_h((float)kv[0] * w, (float)kv[1] * w); o.y = cvtpk_h((float)kv[2] * w, (float)kv[3] * w); o.z = cvtpk_h((float)kv[4] * w, (float)kv[5] * w); o.w = cvtpk_h((float)kv[6] * w, (float)kv[7] * w); \
            *(LAS u32x4*)(lds + SC_K + buf + soff + j * 4096) = o; } \
        SC_LOAD(KR, VR, ci + 4); \
        if (wid < 4) { LAS h16* cs = (LAS h16*)(lds + SC_CST + (ci & 1) * 8192); _Pragma("unroll") for (int r = 0; r < 16; ++r) cs[(32 * dblk + crow(r, hi)) * 64 + 32 * eblk + r32] = (h16)Cacc[r]; \
            if (wid < 2 && hi == 0) *(GAS float*)((float*)(st + 8192) + 32 * eblk + r32) = nacc; if (wid == 0 && lane == 0) *(GAS float*)(st + 8192 + 256) = m; } \
        BAR_LDS(); \
        *(GAS u32x4*)(st + tid * 16) = *(const LAS u32x4*)(lds + SC_CST + (ci & 1) * 8192 + tid * 16);     \
        const float Gmax = GMA[ci], bend = BEA[ci]; \
        const float Mend = fmaxf(m, Gmax), fd = __builtin_amdgcn_exp2f((m - Mend) * LOG2E), fu = __builtin_amdgcn_exp2f((Gmax - Mend) * LOG2E); \
        if (wid < 4) { f32x16 U = f32x16{}, U2 = f32x16{}; const s16x8 ones = (s16x8){0x3C00, 0x3C00, 0x3C00, 0x3C00, 0x3C00, 0x3C00, 0x3C00, 0x3C00}; \
            _Pragma("unroll") for (int ks = 0; ks < 8; ++ks) { const s16x8 a = tr_frag((LAS const char*)lds + SC_V + buf, 8192, dblk, ks, lane), bb = tr_frag((LAS const char*)lds + SC_K + buf, 8192, eblk, ks, lane); \
                U = __builtin_amdgcn_mfma_f32_32x32x16_f16(H8(a), H8(bb), U, 0, 0, 0); if (wid < 2) U2 = __builtin_amdgcn_mfma_f32_32x32x16_f16(H8(ones), H8(bb), U2, 0, 0, 0); }     \
            _Pragma("unroll") for (int r = 0; r < 16; ++r) Cacc[r] = fd * Cacc[r] + fu * U[r]; \
            if (wid < 2) nacc = fd * nacc + fu * U2[0]; } \
        m = bend + Mend; } } while (0)
#pragma unroll 1
    for (int c4 = 0; c4 < NCHUNK; c4 += 4) { SC_BODY(kA, vA, c4); SC_BODY(kB, vB, c4 + 1); SC_BODY(kC, vC, c4 + 2); SC_BODY(kD, vD, c4 + 3); }
#undef SC_BODY
#undef SC_LOAD
    VM_WAIT(); __syncthreads();
    if (tid == 0) { __builtin_amdgcn_fence(__ATOMIC_RELEASE, "agent"); VM_WAIT(); __hip_atomic_store(flag, 1u, RLX_AGENT); }
}

constexpr int MO_K = 0, MO_V = 16384, MO_GA = 32768, MO_N = 36864, MO_M0 = 37376, MO_WS = 37888, MO_OST = 40960, MO_GH = 106496;
struct MoutPre { u32x4 kv[2], vv[2]; s16x8 qr[4]; GateRaw graw; float m0g, nval; };
__device__ __forceinline__ size_t mout_rb(int b, int tc) { return tc < 2 ? (size_t)MLAT + (size_t)b * CTXL + 128 * tc : (size_t)b * SEQ + 128 * (tc - 2); }
__device__ __forceinline__ void mout_load(MoutPre& R, unsigned char* ws, int b, int h, int tc, int tid) {
    const int lane = tid & 63, wid = tid >> 6, r32 = lane & 31, hi = lane >> 5, dir = wid >> 2, wl = wid & 3;
    const h16* CQ = (const h16*)(ws + WS_CQ); const h16* CK = (const h16*)(ws + WS_CK); const h16* CV = (const h16*)(ws + WS_CV); const float* G = (const float*)(ws + WS_G);
    const size_t rb = mout_rb(b, tc);
#pragma unroll
    for (int j = 0; j < 2; ++j) { const int i = tid + 512 * j, row = i >> 3, c8 = i & 7; R.kv[j] = *(const GAS u32x4*)(CK + (rb + row) * 256 + h * 64 + c8 * 8); R.vv[j] = *(const GAS u32x4*)(CV + (rb + row) * 256 + h * 64 + c8 * 8); }
#pragma unroll
    for (int d0 = 0; d0 < 4; ++d0) R.qr[d0] = *(const GAS s16x8*)(CQ + (rb + 32 * wl + r32) * 256 + h * 64 + d0 * 16 + hi * 8);
    R.graw = GateRaw{0.f, 0.f, 0.f, 0.f}; if (wl == 0) R.graw = gate_load(G, rb, h, dir, lane);
}
__device__ __forceinline__ void mout_load_mn(MoutPre& R, unsigned char* ws, int b, int h, int tc, int tid) {
    const int lane = tid & 63, wid = tid >> 6, dir = wid >> 2, wl = wid & 3;
    const int ci = tc < 2 ? (dir ? 1 - tc : tc) : 2 + (dir ? 15 - (tc - 2) : tc - 2);
    const unsigned char* st = state_ptr(ws, b, h, dir, ci);
    R.m0g = 0.f; R.nval = 0.f; if (wl == 0) { R.m0g = *(const GAS float*)(st + 8192 + 256); R.nval = *(const GAS float*)((const float*)(st + 8192) + lane); }
}
__device__ __forceinline__ void mlstm_out_loop(unsigned char* ws, h16* Y, const float* ghead  , int u  , const int o_mout, const int o_end, const int ntc, const bool ctx_out,
                                               gu32* head, gu32* chain  , volatile LAS unsigned* acq, volatile LAS int* slot, LAS unsigned char* lds, char* shm, int tid) {
    const int lane = tid & 63, wid = __builtin_amdgcn_readfirstlane(tid >> 6), r32 = lane & 31, hi = lane >> 5, dir = wid >> 2, wl = wid & 3;
    int b, h, tc; { const int a = u - o_mout, tci = a % ntc, bh = a / ntc; b = bh >> 2; h = bh & 3; tc = ctx_out ? tci : tci + 2; }
    MoutPre R; mout_load(R, ws, b, h, tc, tid); bool have_mn = false;
    { LAS float* GH = (LAS float*)(lds + MO_GH); if (tid < 256) GH[tid] = *(const GAS float*)(ghead + tid); }
    unsigned tk = 0u; if (tid == 0) tk = __hip_atomic_fetch_add(head, 1u, RLX_AGENT);
    for (;;) {
        const unsigned nxt = tk; if (tid == 0) tk = __hip_atomic_fetch_add(head, 1u, RLX_AGENT);
        const size_t rb = mout_rb(b, tc);
        const int ci = tc < 2 ? (dir ? 1 - tc : tc) : 2 + (dir ? 15 - (tc - 2) : tc - 2);
        const unsigned char* st = state_ptr(ws, b, h, dir, ci);
        if (*acq == 0u) {
            __syncthreads();
            if (wid == 0) { unsigned sp = 0; for (;;) { const unsigned f0 = __hip_atomic_load(chain + 64 * lane, RLX_AGENT), f1 = __hip_atomic_load(chain + 64 * (lane + 64), RLX_AGENT);
                    if (__all(f0 != 0u && f1 != 0u)) break; __builtin_amdgcn_s_sleep(8); if (++sp > (1u << 20)) break; }
                __builtin_amdgcn_fence(__ATOMIC_ACQUIRE, "agent"); VM_WAIT(); if (lane == 0) *acq = 1u; }
            __syncthreads();
        }
        if (!have_mn) { mout_load_mn(R, ws, b, h, tc, tid); have_mn = true; }
        const float m0g = R.m0g, nval = R.nval;
        s16x8 cf[4][2];
#pragma unroll
        for (int ks = 0; ks < 4; ++ks)
#pragma unroll
            for (int d0 = 0; d0 < 2; ++d0) cf[ks][d0] = *(const GAS s16x8*)((const h16*)st + (32 * d0 + r32) * 64 + 16 * ks + 8 * hi);
#pragma unroll
        for (int j = 0; j < 2; ++j) { const int i = tid + 512 * j, row = i >> 3, c8 = i & 7, sl = row >> 6, r = row & 63;
            *(LAS u32x4*)(lds + MO_K + sl * 8192 + c8 * 1024 + r * 16) = R.kv[j];
            *(LAS u32x4*)(lds + MO_V + sl * 8192 + ((c8 >> 2) * 4 + (r >> 4)) * 1024 + (r & 15) * 64 + (c8 & 3) * 16) = R.vv[j]; }
        s16x8 qr[4];
#pragma unroll
        for (int d0 = 0; d0 < 4; ++d0) qr[d0] = R.qr[d0];
        LAS float* bL = (LAS float*)(lds + MO_GA + dir * 1536); LAS float* gL = bL + 128; LAS float* ML = bL + 256; LAS float* NL = (LAS float*)(lds + MO_N + dir * 256); LAS float* M0 = (LAS float*)(lds + MO_M0);
        if (wl == 0) { float Gm, be; gate_compute(R.graw, dir, m0g, bL, gL, ML, lane, Gm, be); NL[lane] = nval; if (lane == 0) M0[dir] = m0g; }
        if (tid == 0) *slot = (int)nxt;
        BAR_LDS();
        const int un = __builtin_amdgcn_readfirstlane(*slot); const bool more = un < o_end;
        int nb = 0, nh = 0, ntcv = 0;
        if (more) { const int a = un - o_mout, tci = a % ntc, bh = a / ntc; nb = bh >> 2; nh = bh & 3; ntcv = ctx_out ? tci : tci + 2; mout_load(R, ws, nb, nh, ntcv, tid); mout_load_mn(R, ws, nb, nh, ntcv, tid); }
        const int frow = tid >> 2, fcq = tid & 3; const size_t fgo = (rb + frow) * 256 + h * 64 + fcq * 16;
        const h16x8 co0 = *(const GAS h16x8*)((const h16*)(ws + WS_CO) + fgo), co1 = *(const GAS h16x8*)((const h16*)(ws + WS_CO) + fgo + 8), cz0 = *(const GAS h16x8*)((const h16*)(ws + WS_CZ) + fgo), cz1 = *(const GAS h16x8*)((const h16*)(ws + WS_CZ) + fgo + 8);
        const int t = 32 * wl + r32;
        const float m0 = M0[dir], Mt = ML[t], bt = bL[t], inter = __builtin_amdgcn_exp2f((m0 - Mt) * LOG2E);
        f32x16 o[2]; o[0] = f32x16{}; o[1] = f32x16{}; float sacc = 0.f; const f32x16 zero16 = f32x16{};
        const unsigned lds0 = (unsigned)(uintptr_t)shm;
        { float dq = 0.f; const h16 ih = (h16)inter;
#pragma unroll
          for (int ks = 0; ks < 4; ++ks) { const h16x8 q8 = H8(qr[ks]); const f32x4 n0 = *(const LAS f32x4*)(NL + 16 * ks + 8 * hi), n1 = *(const LAS f32x4*)(NL + 16 * ks + 8 * hi + 4);
              dq += ((float)q8[0] * n0[0] + (float)q8[1] * n0[1]) + ((float)q8[2] * n0[2] + (float)q8[3] * n0[3]) + ((float)q8[4] * n1[0] + (float)q8[5] * n1[1]) + ((float)q8[6] * n1[2] + (float)q8[7] * n1[3]);
              const h16x8 qs = q8 * ih;
#pragma unroll
              for (int d0 = 0; d0 < 2; ++d0) o[d0] = __builtin_amdgcn_mfma_f32_32x32x16_f16(qs, H8(cf[ks][d0]), o[d0], 0, 0, 0); }
          sacc += inter * dq; }
#pragma unroll
        for (int kb = 0; kb < 2; ++kb) {
            const bool need = dir ? (kb == 1 || wl <= 1) : (kb == 0 || wl >= 2);
            if (need) {
                f32x16 p0, p1; attn_body::qkt(p0, p1, shm + MO_K + kb * 8192, qr, zero16, r32, hi);
#pragma unroll
                for (int i = 0; i < 4; ++i) { const f32x4 ga = *(const LAS f32x4*)(gL + 64 * kb + 8 * i + 4 * hi), gb = *(const LAS f32x4*)(gL + 64 * kb + 32 + 8 * i + 4 * hi);
#pragma unroll
                    for (int jj = 0; jj < 4; ++jj) { const int r = 4 * i + jj, s0 = 64 * kb + 8 * i + 4 * hi + jj, s1 = s0 + 32;
                        const bool k0 = dir ? (s0 >= t) : (s0 <= t), k1 = dir ? (s1 >= t) : (s1 <= t);
                        const float w0 = k0 ? p0[r] * __builtin_amdgcn_exp2f((ga[jj] - Mt) * LOG2E) : 0.f, w1 = k1 ? p1[r] * __builtin_amdgcn_exp2f((gb[jj] - Mt) * LOG2E) : 0.f;
                        p0[r] = w0; p1[r] = w1; sacc += w0 + w1; } }
                u32x4 pw0, pw1, pw2, pw3;
#define PKW(P, B) cvtpk_h(P[B], P[B + 1])
                pw0 = (u32x4){PKW(p0, 0), PKW(p0, 2), PKW(p0, 4), PKW(p0, 6)}; pw1 = (u32x4){PKW(p0, 8), PKW(p0, 10), PKW(p0, 12), PKW(p0, 14)};
                pw2 = (u32x4){PKW(p1, 0), PKW(p1, 2), PKW(p1, 4), PKW(p1, 6)}; pw3 = (u32x4){PKW(p1, 8), PKW(p1, 10), PKW(p1, 12), PKW(p1, 14)};
#undef PKW
                const int vb = (int)(lds0 + MO_V + kb * 8192) + ((lane >> 4) & 1) * 32 + (lane & 3) * 8 + (4 * hi + ((lane & 15) >> 2)) * 64;
                attn_body::pv(o, vb, __builtin_bit_cast(s16x8, pw0), __builtin_bit_cast(s16x8, pw1), __builtin_bit_cast(s16x8, pw2), __builtin_bit_cast(s16x8, pw3));
            }
        }
        { auto rr = __builtin_amdgcn_permlane32_swap(__float_as_uint(sacc), __float_as_uint(sacc), false, false); sacc = __uint_as_float(rr[0]) + __uint_as_float(rr[1]); }
        const float hden = fmaxf(fabsf(sacc), __builtin_amdgcn_exp2f(-(bt + Mt) * LOG2E));
        LAS float* wsf = (LAS float*)(lds + MO_WS) + wid * 64;
        if (hi == 0) wsf[r32] = __builtin_amdgcn_rcpf(hden);
        LDS_WAIT();
        LAS float* ost = (LAS float*)(lds + MO_OST) + wid * 2048;
#pragma unroll
        for (int r = 0; r < 16; ++r) { const int orow = crow(r, hi); const float rl = wsf[orow];
#pragma unroll
            for (int d0 = 0; d0 < 2; ++d0) ost[orow * 64 + d0 * 32 + r32] = o[d0][r] * rl; }
        BAR_LDS();
        { const int wt = frow >> 5, tr = frow & 31; const LAS float* pf = (const LAS float*)(lds + MO_OST) + wt * 2048 + tr * 64 + fcq * 16; const LAS float* pb = pf + 4 * 2048;
          float x[16]; float ss = 0.f;
#pragma unroll
          for (int i = 0; i < 4; ++i) { const f32x4 a = *(const LAS f32x4*)(pf + 4 * i), c = *(const LAS f32x4*)(pb + 4 * i);
#pragma unroll
              for (int j = 0; j < 4; ++j) { x[4 * i + j] = a[j] + c[j]; ss += x[4 * i + j] * x[4 * i + j]; } }
          ss = quad_sum(ss);
          const float rn = __builtin_amdgcn_rsqf(ss * (1.f / 64.f) + EPS); const LAS float* gh = (const LAS float*)(lds + MO_GH) + h * 64 + fcq * 16;
          float y[16];
#pragma unroll
          for (int j = 0; j < 8; ++j) { y[j] = sigmf((float)co0[j]) * (x[j] * rn * gh[j]) * siluf((float)cz0[j]); y[8 + j] = sigmf((float)co1[j]) * (x[8 + j] * rn * gh[8 + j]) * siluf((float)cz1[j]); }
          u32x4 w0, w1; w0.x = cvtpk_h(y[0], y[1]); w0.y = cvtpk_h(y[2], y[3]); w0.z = cvtpk_h(y[4], y[5]); w0.w = cvtpk_h(y[6], y[7]); w1.x = cvtpk_h(y[8], y[9]); w1.y = cvtpk_h(y[10], y[11]); w1.z = cvtpk_h(y[12], y[13]); w1.w = cvtpk_h(y[14], y[15]);
          h16* yp = Y + (rb + frow) * D + 768 + h * 64 + fcq * 16; *(GAS u32x4*)yp = w0; *(GAS u32x4*)(yp + 8) = w1; }
        BAR_LDS();
        if (!more) break;
        b = nb; h = nh; tc = ntcv;
    }
}
#undef H8
}
__device__ __forceinline__ int q_first(Frame& F, gu32* head) {
    volatile LAS int* slot = (volatile LAS int*)(F.lds + MISC_OFF + 256);
    __syncthreads();
    if (F.tid == 0) *slot = (int)__hip_atomic_fetch_add(head, 1u, RLX_AGENT);
    __syncthreads();
    return __builtin_amdgcn_readfirstlane(*slot);
}
__device__ __forceinline__ void ph_mixers(Frame& F, int l, int rep) {
    unsigned char* ws = F.p.ws; const bool ctx_out = l < DEPTH - 1;
    const int pm_ = rep ? PROBE_MIX : 15;
    const int n_scan = (FAST_MLSTM && (pm_ & 1)) ? 128 : 0;
    const int n_attn = (FAST_ATTN && (pm_ & 2)) ? 1024 : 0, n_attc = (FAST_ATTN && ctx_out && (pm_ & 2)) ? 128 : 0;
    const int n_gmlp = (FAST_GMLP && (pm_ & 4)) ? (ctx_out ? MROWS / 128 : MLAT / 128) : 0;
    const int ntc = ctx_out ? 18 : 16, n_mout = (FAST_MLSTM && (pm_ & 8)) ? 64 * ntc : 0;
    const int o_attn = n_scan, o_attc = o_attn + n_attn, o_gmlp = o_attc + n_attc, o_mout = o_gmlp + n_gmlp, o_end = o_mout + n_mout;
    gu32* head = F.ctl + CW_QUEUE + 64 * (l + 4 * rep); gu32* chain = F.ctl + CW_CHAIN + 64 * (l * 128);
    if (F.tid == 0) *(volatile LAS unsigned*)(F.lds + MISC_OFF + 320) = 0u;
    int u = q_first(F, head);
    while (u < o_end) {
        if (u >= o_mout) {
            int tidm = F.tid; asm volatile("" : "+v"(tidm)); unsigned lo2 = 0; asm volatile("" : "+s"(lo2)); LAS unsigned char* ldsm = F.lds + lo2; unsigned char* wsm = F.p.ws; asm volatile("" : "+s"(wsm));
            mx::mlstm_out_loop(wsm, (h16*)F.p.out, F.p.ghead + l * 256, u, o_mout, o_end, ntc, ctx_out, head, chain, (volatile LAS unsigned*)(F.lds + MISC_OFF + 320), (volatile LAS int*)(F.lds + MISC_OFF + 256), ldsm, (char*)ldsm, tidm);
            break;
        }
        unsigned nxt = 0u;
        if (F.tid == 0) nxt = __hip_atomic_fetch_add(head, 1u, RLX_AGENT);
        int tid = F.tid; asm volatile("" : "+v"(tid));
        unsigned lofs = 0; asm volatile("" : "+s"(lofs)); LAS unsigned char* lds = F.lds + lofs;
        { unsigned char* w2 = F.p.ws; asm volatile("" : "+s"(w2)); ws = w2; }
        if (u < o_attn) {
            mx::scan_unit(ws, u >> 3, (u >> 1) & 3, u & 1, chain + 64 * u, lds, tid);
        } else if (u < o_gmlp) {
            const bool isl = u < o_attc; const int a = isl ? u - o_attn : u - o_attc;
            const int qb = isl ? (a & 7) : 0, g = isl ? (a >> 3) : a, hq = g & 3, kvh = (g >> 2) & 1, b = g >> 3, h = kvh * 4 + hq;
            const h16* Q = (const h16*)(ws + WS_Q); const h16* KB = (const h16*)(ws + WS_KB); const h16* VB = (const h16*)(ws + WS_VB); const h16* BZ = (const h16*)(ws + WS_BZ); h16* Y = (h16*)F.p.out;
            const size_t row0 = isl ? (size_t)b * SEQ + qb * 256 : (size_t)MLAT + (size_t)b * CTXL; const size_t kvo = ((size_t)(b * 2 + kvh) * NKEY) * 64;
            const float mfx = *(const GAS float*)(ws + WS_ROPE + 8192 + 4 * l);
            if (mfx <= -1.f) attn_body::attn_unit<8, true>(Q + row0 * 512 + h * 64, KB + kvo, VB + kvo, isl ? NKEY / 64 : CTXL / 64, Y + row0 * D + 256 + h * 64, BZ + row0 * 512 + h * 64, (char*)lds, tid, mfx);
            else attn_body::attn_unit<8, false>(Q + row0 * 512 + h * 64, KB + kvo, VB + kvo, isl ? NKEY / 64 : CTXL / 64, Y + row0 * D + 256 + h * 64, BZ + row0 * 512 + h * 64, (char*)lds, tid, mfx);
        } else if (u < o_mout) {
            mx::gmlp_unit(ws, (h16*)F.p.out, (const h16*)(ws + WS_WS16) + (size_t)l * 4 * 128 * 128, F.p.bsp + l * 512, (size_t)(u - o_gmlp) * 128, lds, tid);
        }
        { volatile LAS int* slot = (volatile LAS int*)(F.lds + MISC_OFF + 256);
          BAR_LDS(); if (F.tid == 0) *slot = (int)nxt; BAR_LDS(); u = __builtin_amdgcn_readfirstlane(*slot); }
    }
}
constexpr int PH_FINAL = 2 + 3 * DEPTH, NPHASE = PH_FINAL + 1;
struct Args { Ptrs p; int ph_lo, ph_hi, li, pad; };

__device__ __forceinline__ void ph_inproj(Frame& F, int l, bool dry, bool nost) {
    unsigned char* ws = F.p.ws;
    pg8::Gemm g{(const h16*)(ws + WS_XS), (const h16*)(ws + WS_WINT) + (size_t)l * NPAD * D, MROWS, NPAD, D};
    pg8::StaticOrder S; S.init(MROWS, NPAD, F.G, F.bid);
    { const float* rt = (const float*)(ws + WS_ROPE); LAS float* rl = (LAS float*)(F.lds + ROPE_LDS_OFF); for (int i = F.tid; i < 2048; i += NTHREADS) rl[i] = *(const GAS float*)(rt + i); __syncthreads(); }
    EpiIn E{(unsigned)(WS_SHW + (size_t)l * 17 * NPAD * 4), F.p.gq + l * 64, F.p.gk + l * 64, F.p.bgates + l * 16, ws, nost ? nullptr : ws, (const LAS float*)(F.lds + ROPE_LDS_OFF)};
#if PROBE_BF16
    if (dry) pg8::gemm_phase<EpiIn, true, true, true>(F.lds, F.tid, g, S, E, dry); else
#endif
    pg8::gemm_phase<EpiIn, true, true>(F.lds, F.tid, g, S, E, dry);
}
__device__ __forceinline__ void ph_outproj(Frame& F, int l, float gscale, bool dry) {
    unsigned char* ws = F.p.ws; const bool last = l == DEPTH - 1; const int Mr = last ? MLAT : MROWS;
    pg8::Gemm g{(const h16*)F.p.out, (const h16*)(ws + WS_WOT) + (size_t)l * D * D, Mr, D, D};
    pg8::StaticOrder S; S.init(Mr, D, F.G, F.bid);
    EpiOut E{(unsigned)(WS_MOD + ((size_t)l * 17 * 3072 + 2048) * 4), last ? 0u : (unsigned)(WS_AMOD + (size_t)(l + 1) * 17 * 1024 * 4), ws, gscale};
    pg8::gemm_phase<EpiOut, true, true>(F.lds, F.tid, g, S, E, dry);
}

__global__ void __launch_bounds__(NTHREADS, 2) mega(Args a) {
    extern __shared__ __attribute__((aligned(16))) unsigned char lds[];
    Frame F; F.lds = (LAS unsigned char*)lds; F.tid = threadIdx.x; F.lane = F.tid & 63; F.wave = __builtin_amdgcn_readfirstlane(F.tid >> 6); F.G = gridDim.x; F.p = a.p;
    F.ctl = (gu32*)(a.p.ws + WS_CTL);
    volatile LAS unsigned* MISC = (volatile LAS unsigned*)(F.lds + MISC_OFF);
    for (int u = F.tid; u < 256; u += NTHREADS) MISC[u] = 0u;
    __syncthreads();
    XcdBarrier bar; bar.bar = (unsigned*)(F.ctl + CW_BAR) + a.li * XCD_BAR_WORDS; bar.x = 0; bar.st = nullptr;
    if (a.ph_hi - a.ph_lo > 1) bar = xcd_barrier_post((unsigned*)(F.ctl + CW_BAR) + a.li * XCD_BAR_WORDS, MISC + 8);
    const int wave0 = __builtin_amdgcn_readfirstlane(threadIdx.x >> 6);
    for (int pp = 2 * a.ph_lo; pp < 2 * a.ph_hi; ++pp) {
        const int ph = pp >> 1, rep = pp & 1;
        const int kk = (ph >= 2 && ph < PH_FINAL) ? (ph - 2) % 3 : 3; const bool dupk = ((PROBE_DUP >> kk) & 1) != 0 && ph != PH_FINAL;
        if (!dupk && rep == 1) continue;
        { int wv = wave0; asm volatile("" : "+s"(wv)); int ln = (int)__builtin_amdgcn_mbcnt_hi(~0u, __builtin_amdgcn_mbcnt_lo(~0u, 0u)); asm volatile("" : "+v"(ln)); const int t = wv * 64 + ln; F.tid = t; F.lane = ln; F.wave = wv;
          int bx = blockIdx.x; asm volatile("" : "+s"(bx)); F.bid = bx;
          unsigned char* w = a.p.ws; asm volatile("" : "+s"(w)); F.p.ws = w;
          unsigned lb = 0; asm volatile("" : "+s"(lb)); F.lds = (LAS unsigned char*)lds + lb; }
        if (ph == 0) p0ab(F);
        else if (ph == 1) p0c(F);
        else if (ph == PH_FINAL) p_final(F);
        else { const int l = (ph - 2) / 3, k = (ph - 2) % 3;
            const bool dup = ((PROBE_DUP >> k) & 1) != 0;
            const bool dry = PROBE_NOEPI && dup && rep == 0;
            if (k == 0) ph_inproj(F, l, dry, PROBE_NOSTORE && dup && rep == 0);
            else if (k == 1) ph_mixers(F, l, rep);
            else ph_outproj(F, l, (dup && rep == 0) ? 0.f : 1.f, dry); }
        if (!(ph == a.ph_hi - 1 && (rep == 1 || !dupk))) xcd_barrier(bar);
#if PROBE_XBAR
        if (ph == 1) { for (int xb = 0; xb < PROBE_XBAR; ++xb) xcd_barrier(bar); }
#endif
    }
}

extern "C" void kernel_launch(void* const* d_in, const int* in_sizes, int n_in, void* d_out, int out_size, void* d_ws, size_t ws_size, hipStream_t stream) {
    static int grid = 0;
    if (grid == 0) {
        if (n_in != 16 || ws_size < WS_END) { fprintf(stderr, "kernel_launch: unexpected n_in %d / ws %zu (need %zu)\n", n_in, ws_size, (size_t)WS_END); grid = -1; return; }
        int dev = 0, cus = 0, per_cu = 0;
        hipGetDevice(&dev); hipDeviceGetAttribute(&cus, hipDeviceAttributeMultiprocessorCount, dev);
        if (hipFuncSetAttribute((const void*)mega, hipFuncAttributeMaxDynamicSharedMemorySize, LDS_BYTES) != hipSuccess) { fprintf(stderr, "kernel_launch: hipFuncSetAttribute failed\n"); grid = -1; return; }
        hipOccupancyMaxActiveBlocksPerMultiprocessor(&per_cu, (const void*)mega, NTHREADS, LDS_BYTES);
        (void)hipGetLastError();
        if (per_cu < 1) fprintf(stderr, "kernel_launch: occupancy query says %d blocks/CU\n", per_cu);
        grid = cus;
    }
    if (grid < 0) return;
    hipMemsetAsync((char*)d_ws + WS_CTL, 0, CTL_ZERO_BYTES, stream);
    Args a{};
    const float** pp = (const float**)&a.p;
    for (int i = 0; i < 16; ++i) pp[i] = (const float*)d_in[i];
    a.p.out = (float*)d_out; a.p.ws = (unsigned char*)d_ws;
    int li = 0;
    auto launch = [&](int lo, int hi) { a.ph_lo = lo; a.ph_hi = hi; a.li = (hi - lo > 1) ? li++ : 0; hipLaunchKernelGGL(mega, dim3(grid), dim3(NTHREADS), LDS_BYTES, stream, a); };
#if ONE_LAUNCH
    launch(0, NPHASE);
#else
    launch(0, 1); launch(1, 2);
    for (int l = 0; l < DEPTH; ++l) {
        launch(2 + 3 * l, 3 + 3 * l);
        launch(3 + 3 * l, 4 + 3 * l);
        launch(4 + 3 * l, 5 + 3 * l);
    }
    launch(PH_FINAL, NPHASE);
#endif
}
```

```cpp
#define FAST_ATTN 1
#define FAST_GMLP 1
#define FAST_MLSTM 1
#define ONE_LAUNCH 1
#include <hip/hip_runtime.h>
#include <cstdio>
#include <cstdint>

#ifndef FAST_ATTN
#define FAST_ATTN 0
#endif
#ifndef FAST_GMLP
#define FAST_GMLP 0
#endif
#ifndef FAST_MLSTM
#define FAST_MLSTM 0
#endif
#ifndef ONE_LAUNCH
#define ONE_LAUNCH 0
#endif
#ifndef PROBE_NOEPI
#define PROBE_NOEPI 0
#endif
#ifndef PROBE_MIX
#define PROBE_MIX 15
#endif
#ifndef PROBE_NOSTORE
#define PROBE_NOSTORE 0
#endif
#ifndef PROBE_LIM
#define PROBE_LIM 0
#endif
#ifndef WT_STORES
#define WT_STORES 0
#endif
#ifndef PROBE_XBAR
#define PROBE_XBAR 0
#endif
#ifndef PROBE_BF16
#define PROBE_BF16 0
#endif
#ifndef PROBE_DUP
#define PROBE_DUP 0
#endif
#define LAS __attribute__((address_space(3)))
#define GAS __attribute__((address_space(1)))
typedef _Float16 h16;
typedef _Float16 h16x8 __attribute__((ext_vector_type(8)));
typedef _Float16 h16x4 __attribute__((ext_vector_type(4)));
typedef _Float16 h16x2 __attribute__((ext_vector_type(2)));
typedef float f32x2 __attribute__((ext_vector_type(2)));
typedef float f32x4 __attribute__((ext_vector_type(4)));
typedef float f32x16 __attribute__((ext_vector_type(16)));
typedef unsigned u32x4 __attribute__((ext_vector_type(4)));
typedef unsigned u32x2 __attribute__((ext_vector_type(2)));
typedef short s16x4 __attribute__((ext_vector_type(4)));
typedef short v4i16_t __attribute__((ext_vector_type(4)));

constexpr int D = 1024, NB = 16, SEQ = 2048, DEPTH = 4, CTXL = 256, DIN = 3344, NPAD = 3584;
constexpr int MLAT = NB * SEQ, MCTX = NB * CTXL, MROWS = MLAT + MCTX;
constexpr int NKEY = CTXL + SEQ;
constexpr int NCHUNK = 18;
constexpr float EPS = 1e-6f;
constexpr float QSCALE = 0.125f * 1.4426950408889634f;

constexpr size_t MiB = 1u << 20;
constexpr size_t WS_CTL = 0, CTL_ZERO_BYTES = 1 * MiB;
constexpr size_t WS_WINT = 1 * MiB;
constexpr size_t WS_WOT = 29 * MiB;
constexpr size_t WS_WS16 = 37 * MiB;
constexpr size_t WS_MOD = WS_WS16 + MiB / 2;
constexpr size_t WS_SHW = WS_MOD + MiB;
constexpr size_t WS_AMOD = WS_SHW + MiB;
constexpr size_t WS_ROPE = WS_AMOD + MiB / 2;
constexpr size_t WS_ROWSQ = WS_ROPE + MiB / 2;
constexpr size_t WS_G = WS_ROWSQ + 5 * MiB / 2;
constexpr size_t WS_XC = WS_G + 5 * MiB / 2;
constexpr size_t WS_XS = WS_XC + 16 * MiB;
constexpr size_t WS_GU = WS_XS + 72 * MiB;
constexpr size_t WS_VN = WS_GU + 18 * MiB;
constexpr size_t WS_SZ = WS_VN + 18 * MiB;
constexpr size_t WS_Q = WS_SZ + 18 * MiB;
constexpr size_t WS_BZ = WS_Q + 36 * MiB;
constexpr size_t WS_KB = WS_BZ + 36 * MiB;
constexpr size_t WS_VB = WS_KB + 9 * MiB;
constexpr size_t WS_CQ = WS_VB + 9 * MiB;
constexpr size_t WS_CK = WS_CQ + 18 * MiB;
constexpr size_t WS_CV = WS_CK + 18 * MiB;
constexpr size_t WS_CO = WS_CV + 18 * MiB;
constexpr size_t WS_CZ = WS_CO + 18 * MiB;
constexpr size_t WS_X16 = WS_CZ + 18 * MiB;
constexpr size_t WS_ST = WS_X16 + 72 * MiB;
constexpr size_t ST_STRIDE = 8192 + 512;
constexpr size_t WS_HF = WS_ST + 20 * MiB;
constexpr size_t WS_HB = WS_HF + 18 * MiB;
constexpr size_t WS_END = WS_HB + 18 * MiB;
static_assert(WS_END <= 512 * MiB, "d_ws map");
static_assert((size_t)NB * 4 * 2 * NCHUNK * ST_STRIDE <= 20 * MiB, "state region");

constexpr int CW_TMO = 0;
constexpr int CW_BAR = 4096;
constexpr int CW_QUEUE = 16384;
constexpr int CW_CHAIN = 32768;

struct Ptrs {
    const float *x, *c, *ctx, *cctx, *wada, *bada, *gnorm, *win, *wsp, *bsp, *gq, *gk, *bgates, *ghead, *wout, *gfinal;
    float* out; unsigned char* ws;
};

__device__ __forceinline__ float siluf(float x) { return x * __builtin_amdgcn_rcpf(1.f + __builtin_amdgcn_exp2f(-1.4426950408889634f * x)); }
__device__ __forceinline__ float sigmf(float x) { return __builtin_amdgcn_rcpf(1.f + __builtin_amdgcn_exp2f(-1.4426950408889634f * x)); }
__device__ __forceinline__ float geluf(float x) { return x * __builtin_amdgcn_rcpf(1.f + __builtin_amdgcn_exp2f(x * (-0.10294324f * x * x - 2.3022082f))); }
__device__ __forceinline__ float logsigf(float x) { return fminf(x, 0.f) - 0.6931471805599453f * __builtin_amdgcn_logf(1.f + __builtin_amdgcn_exp2f(-1.4426950408889634f * fabsf(x))); }
__device__ __forceinline__ float lx_xor(float v, int m, int lane) { return __int_as_float(__builtin_amdgcn_ds_bpermute((lane ^ m) << 2, __float_as_int(v))); }
__device__ __forceinline__ float lx_up(float v, int o, int lane) { return __int_as_float(__builtin_amdgcn_ds_bpermute((lane - o) << 2, __float_as_int(v))); }
__device__ __forceinline__ float lx_get(float v, int src) { return __int_as_float(__builtin_amdgcn_readlane(__float_as_int(v), src)); }
template <int CTRL> __device__ __forceinline__ float dpp_f(float v) { return __int_as_float(__builtin_amdgcn_update_dpp(0, __float_as_int(v), CTRL, 0xF, 0xF, false)); }
__device__ __forceinline__ float oct_sum(float s) { s += dpp_f<0xB1>(s); s += dpp_f<0x4E>(s); s += dpp_f<0x141>(s); return s; }
__device__ __forceinline__ unsigned cvtpk_h(float lo, float hi) { f32x2 v = {lo, hi}; h16x2 b = __builtin_convertvector(v, h16x2); return __builtin_bit_cast(unsigned, b); }
namespace pg8 {
typedef __bf16 bf16x8_t __attribute__((ext_vector_type(8)));
constexpr int BM = 256, BK = 64, HALF = 128, HTB = HALF * BK * 2, STAGE_BYTES = 8 * HTB, NXCD = 8, WGM = 8;
__host__ __device__ __forceinline__ int lds_byte(int r, int c) { const int st = (r >> 4) * 2 + (c >> 5), rr = r & 15, cc = c & 31, ob = rr * 64 + cc * 2; return st * 1024 + (ob ^ (((ob >> 9) & 1) << 5)); }
__host__ __device__ __forceinline__ void stage_rc(int b, int& R, int& C) { const int st = b / 1024, sb = b % 1024, swz = sb ^ (((sb >> 9) & 1) << 5); R = (st >> 1) * 16 + swz / 64; C = (st & 1) * 32 + (swz % 64) / 2; }
struct Unit { int pm, pn, hm; };
struct Gemm { const h16* A; const h16* Bt; int M, N, K; };
struct StaticOrder {
    int nM, nN, nwg, G, c, lim;
    __host__ __device__ void init(int M, int N, int G_, int c_) { nM = M / BM; nN = N / BM; nwg = nM * nN; G = G_; c = c_; lim = nwg; }
    __host__ __device__ bool next(int i, Unit& u) const {
        const long L = (long)i * G + c; if (L >= lim) return false;
        unit_of((int)L, u); return true; }
    __host__ __device__ void unit_of(int wgid, Unit& u) const { u.hm = 0; { const int q = nwg / NXCD, r = nwg % NXCD, xcd = wgid % NXCD, off = wgid / NXCD; wgid = (xcd < r ? xcd * (q + 1) : r * (q + 1) + (xcd - r) * q) + off; }
        const int nig = WGM * nN, gid = wgid / nig, fm = gid * WGM, gsz = (nM - fm) < WGM ? (nM - fm) : WGM;
        u.pm = fm + ((wgid % nig) % gsz); u.pn = (wgid % nig) / gsz;
    }
};
struct HalfOrder { StaticOrder S; int base;
    __host__ __device__ bool next(int i, Unit& u) const { if (i != 0 || S.c >= 2 * (S.nwg - base)) return false; S.unit_of(base + (S.c >> 1), u); u.hm = S.c & 1; return true; }
};
template <class Epi, bool ALIGN_EPI, bool SP2, bool BF = false, bool HALFM = false, class Order = StaticOrder>
__device__ __forceinline__ void gemm_phase(LAS unsigned char* lds, const int tid, const Gemm g, const Order& S, const Epi& E, const bool dry = false) {
    const int wid = __builtin_amdgcn_readfirstlane(tid >> 6), lane = tid & 63, wr = wid >> 2, wc = wid & 3, fr = lane & 15, fq = lane >> 4;
    const int K = g.K, nt = K / BK;
    unsigned voffA[2];
#pragma unroll
    for (int i = 0; i < 2; ++i) { int R, C; stage_rc(tid * 16 + i * 8192, R, C); voffA[i] = (unsigned)(R * K + C) * 2u; }
    const size_t kstep = (size_t)(BK * 2);
    const size_t hstep = (size_t)HALF * K * 2;
    const size_t tstep = 2 * hstep;
    const unsigned ldsw = (unsigned)wid * 1024u;
    const int aoff = lds_byte(wr * 64 + fr, fq * 8), boff = lds_byte(wc * 32 + fr, fq * 8);
#define PG8_SA(b, h) (((b) * 2 + (h)) * HTB)
#define PG8_SB(b, h) ((4 + (b) * 2 + (h)) * HTB)
#define PG8_STAGE(bufoff, gbase) do { _Pragma("unroll") for (int _i = 0; _i < 2; ++_i) \
        __builtin_amdgcn_global_load_lds((const unsigned*)((const char*)(gbase) + voffA[_i]), (LAS unsigned*)(lds + (bufoff) + ldsw + _i * 8192), 16, 0, 0); } while (0)
#define PG8_LDA(dst, b, h) do { _Pragma("unroll") for (int m = 0; m < 4; ++m) _Pragma("unroll") for (int k = 0; k < 2; ++k) dst[m][k] = *(const LAS h16x8*)(lds + PG8_SA(b, h) + aoff + m * 2048 + k * 1024); } while (0)
#define PG8_LDB(dst, b, h) do { _Pragma("unroll") for (int n = 0; n < 2; ++n) _Pragma("unroll") for (int k = 0; k < 2; ++k) dst[n][k] = *(const LAS h16x8*)(lds + PG8_SB(b, h) + boff + n * 2048 + k * 1024); } while (0)
#define PG8_MMA(ai, bj, At, Bt) do { __builtin_amdgcn_s_setprio(1); _Pragma("unroll") for (int m = 0; m < 4; ++m) _Pragma("unroll") for (int n = 0; n < 2; ++n) _Pragma("unroll") for (int k = 0; k < 2; ++k) \
        acc[ai][bj][m][n] = BF ? __builtin_amdgcn_mfma_f32_16x16x32_bf16(__builtin_bit_cast(bf16x8_t, Bt[n][k]), __builtin_bit_cast(bf16x8_t, At[m][k]), acc[ai][bj][m][n], 0, 0, 0) : __builtin_amdgcn_mfma_f32_16x16x32_f16(Bt[n][k], At[m][k], acc[ai][bj][m][n], 0, 0, 0); __builtin_amdgcn_s_setprio(0); } while (0)
#define PG8_LDA1(dst, b) do { if constexpr (!HALFM) PG8_LDA(dst, b, 1); } while (0)
#define PG8_MMA1(At, B0, B1) do { if constexpr (!HALFM) { PG8_MMA(1, 0, At, B0); PG8_MMA(1, 1, At, B1); } } while (0)
#define PG8_WAIT_V(n) asm volatile("s_waitcnt vmcnt(" #n ")" ::: "memory")
#define PG8_WAIT_L(n) asm volatile("s_waitcnt lgkmcnt(" #n ")" ::: "memory")
#define PG8_BAR __builtin_amdgcn_s_barrier()
#define PG8_SCHED __builtin_amdgcn_sched_barrier(0)
    Unit cur, nxt; int ui = 0;
    if (!S.next(0, cur)) return;
    f32x4 acc[2][2][4][2];
#pragma unroll
    for (int a = 0; a < 2; ++a)
#pragma unroll
        for (int b = 0; b < 2; ++b)
#pragma unroll
            for (int m = 0; m < 4; ++m)
#pragma unroll
                for (int n = 0; n < 2; ++n) acc[a][b][m][n] = (f32x4){0.f, 0.f, 0.f, 0.f};
    h16x8 At[4][2], B0[2][2], B1[2][2];
    const char* cA = (const char*)g.A + (size_t)cur.pm * tstep + (HALFM ? (size_t)cur.hm * hstep : (size_t)0); const char* cB = (const char*)g.Bt + (size_t)cur.pn * tstep;
    if constexpr (SP2) {
        PG8_STAGE(PG8_SB(0, 0), cB); PG8_STAGE(PG8_SB(0, 1), cB + hstep); PG8_STAGE(PG8_SA(0, 0), cA); PG8_STAGE(PG8_SA(0, 1), cA + hstep);
        if (wr == 1) PG8_BAR;
        PG8_WAIT_V(2); PG8_BAR;
        PG8_STAGE(PG8_SB(1, 0), cB + kstep); PG8_STAGE(PG8_SA(1, 0), cA + kstep); PG8_STAGE(PG8_SB(1, 1), cB + hstep + kstep);
        PG8_WAIT_V(6); PG8_BAR;
    } else {
        PG8_STAGE(PG8_SB(0, 0), cB); PG8_STAGE(PG8_SA(0, 0), cA); PG8_STAGE(PG8_SB(0, 1), cB + hstep); PG8_STAGE(PG8_SA(0, 1), cA + hstep);
        if (wr == 1) PG8_BAR;
        PG8_WAIT_V(4); PG8_BAR;
        PG8_STAGE(PG8_SB(1, 0), cB + kstep); PG8_STAGE(PG8_SA(1, 0), cA + kstep); PG8_STAGE(PG8_SB(1, 1), cB + hstep + kstep);
        PG8_WAIT_V(6); PG8_BAR;
    }
    for (;;) {
        const bool has_next = S.next(ui + 1, nxt);
        const char* nA = has_next ? (const char*)g.A + (size_t)nxt.pm * tstep + (HALFM ? (size_t)nxt.hm * hstep : (size_t)0) : cA; const char* nB = has_next ? (const char*)g.Bt + (size_t)nxt.pn * tstep : cB;
        for (int t = 0; t < nt; t += 2) {
            const bool last = (t == nt - 2);
            const char* a1 = cA + (size_t)(t + 1) * kstep;
            const char* a2 = last ? nA : cA + (size_t)(t + 2) * kstep; const char* b2 = last ? nB : cB + (size_t)(t + 2) * kstep;
            const char* a3 = a2 + kstep; const char* b3 = b2 + kstep;
            if constexpr (SP2) {
            PG8_LDB(B0, 0, 0); PG8_LDB(B1, 0, 1); PG8_SCHED; PG8_LDA(At, 0, 0); PG8_STAGE(PG8_SA(1, 1), a1 + hstep);
            PG8_WAIT_V(8); PG8_WAIT_L(0); PG8_BAR; PG8_MMA(0, 0, At, B0); PG8_MMA(0, 1, At, B1); PG8_BAR; PG8_SCHED;
            PG8_LDA1(At, 0); PG8_STAGE(PG8_SB(0, 0), b2); PG8_STAGE(PG8_SB(0, 1), b2 + hstep); PG8_STAGE(PG8_SA(0, 0), a2);
            PG8_WAIT_V(8); PG8_WAIT_L(0); PG8_BAR; PG8_MMA1(At, B0, B1); PG8_BAR; PG8_SCHED;
            PG8_LDB(B0, 1, 0); PG8_LDB(B1, 1, 1); PG8_SCHED; PG8_LDA(At, 1, 0); PG8_STAGE(PG8_SA(0, 1), a2 + hstep);
            PG8_WAIT_V(8); PG8_WAIT_L(0); PG8_BAR; PG8_MMA(0, 0, At, B0); PG8_MMA(0, 1, At, B1); PG8_BAR; PG8_SCHED;
            PG8_LDA1(At, 1); PG8_STAGE(PG8_SB(1, 0), b3); PG8_STAGE(PG8_SB(1, 1), b3 + hstep); PG8_STAGE(PG8_SA(1, 0), a3);
            PG8_WAIT_V(8); PG8_WAIT_L(0); PG8_BAR; PG8_MMA1(At, B0, B1); PG8_BAR; PG8_SCHED;
            } else {
            PG8_LDB(B0, 0, 0); PG8_SCHED; PG8_LDA(At, 0, 0); PG8_STAGE(PG8_SA(1, 1), a1 + hstep);
            PG8_WAIT_L(8); PG8_BAR; PG8_WAIT_L(0); PG8_MMA(0, 0, At, B0); PG8_BAR; PG8_SCHED;
            PG8_LDB(B1, 0, 1); PG8_STAGE(PG8_SB(0, 0), b2);
            PG8_BAR; PG8_WAIT_L(0); PG8_MMA(0, 1, At, B1); PG8_BAR;
            PG8_LDA(At, 0, 1); PG8_STAGE(PG8_SA(0, 0), a2);
            PG8_BAR; PG8_WAIT_L(0); PG8_MMA(1, 0, At, B0); PG8_BAR; PG8_SCHED;
            PG8_STAGE(PG8_SB(0, 1), b2 + hstep);
            PG8_WAIT_V(6); PG8_BAR; PG8_MMA(1, 1, At, B1); PG8_BAR;
            PG8_LDB(B0, 1, 0); PG8_SCHED; PG8_LDA(At, 1, 0); PG8_STAGE(PG8_SA(0, 1), a2 + hstep);
            PG8_WAIT_L(8); PG8_BAR; PG8_WAIT_L(0); PG8_MMA(0, 0, At, B0); PG8_BAR; PG8_SCHED;
            PG8_LDB(B1, 1, 1); PG8_STAGE(PG8_SB(1, 0), b3);
            PG8_BAR; PG8_WAIT_L(0); PG8_MMA(0, 1, At, B1); PG8_BAR;
            PG8_LDA(At, 1, 1); PG8_STAGE(PG8_SA(1, 0), a3);
            PG8_BAR; PG8_WAIT_L(0); PG8_MMA(1, 0, At, B0); PG8_BAR; PG8_SCHED;
            PG8_STAGE(PG8_SB(1, 1), b3 + hstep);
            PG8_WAIT_V(6); PG8_BAR; PG8_MMA(1, 1, At, B1); PG8_BAR;
            }
        }
        if constexpr (ALIGN_EPI) { if (wr == 0) PG8_BAR; }
        if (!dry) { int fr2 = fr, fq2 = fq; asm volatile("" : "+v"(fr2), "+v"(fq2)); E(acc, cur, wr, wc, fr2, fq2); }
        else { _Pragma("unroll") for (int a_ = 0; a_ < 2; ++a_) _Pragma("unroll") for (int b_ = 0; b_ < 2; ++b_) _Pragma("unroll") for (int m_ = 0; m_ < 4; ++m_) _Pragma("unroll") for (int n_ = 0; n_ < 2; ++n_) asm volatile("" :: "v"(acc[a_][b_][m_][n_])); }
        if (!has_next) break;
#pragma unroll
        for (int a = 0; a < 2; ++a)
#pragma unroll
            for (int b = 0; b < 2; ++b)
#pragma unroll
                for (int m = 0; m < 4; ++m)
#pragma unroll
                    for (int n = 0; n < 2; ++n) acc[a][b][m][n] = (f32x4){0.f, 0.f, 0.f, 0.f};
        cur = nxt; cA = nA; cB = nB; ++ui;
        if constexpr (ALIGN_EPI) { if (wr == 1) PG8_BAR; }
    }
    PG8_WAIT_V(0);
    if constexpr (!ALIGN_EPI) { if (wr == 0) PG8_BAR; }
    PG8_BAR;
#undef PG8_SA
#undef PG8_SB
#undef PG8_STAGE
#undef PG8_LDA
#undef PG8_LDB
#undef PG8_MMA
#undef PG8_LDA1
#undef PG8_MMA1
#undef PG8_WAIT_V
#undef PG8_WAIT_L
#undef PG8_BAR
#undef PG8_SCHED
}
}

__host__ __device__ __forceinline__ int tile_pos_of_col(int ca, bool mapA) {
    const int wc = ca >> 6, d = ca & 63, bj = d >> 5, j = d & 3; int n, fq;
    if (mapA) { n = (d >> 4) & 1; fq = (d >> 2) & 3; } else { fq = (d >> 3) & 3; n = (d >> 2) & 1; }
    return 128 * bj + 32 * wc + 16 * n + 4 * fq + j;
}
__host__ __device__ __forceinline__ bool slab_is_mapA(int s) { return s >= 12 && s <= 21; }
__device__ __forceinline__ f32x4 ldg_f4(const void* base, unsigned off) { return *(const GAS f32x4*)((const GAS char*)base + off); }
__device__ __forceinline__ void stg_f4(void* base, unsigned off, f32x4 v) {
#if PROBE_NOSTORE
    if (base == nullptr) { asm volatile("" :: "v"(v)); return; }
#endif
#if WT_STORES
    asm volatile("global_store_dwordx4 %0, %1, %2 sc1\n\ts_nop 1" :: "v"(off), "v"(v), "s"(base) : "memory");
#else
    *(GAS f32x4*)((GAS char*)base + off) = v;
#endif
}
__device__ __forceinline__ void stg_u4(void* base, unsigned off, u32x4 v) {
#if PROBE_NOSTORE
    if (base == nullptr) { asm volatile("" :: "v"(v)); return; }
#endif
#if WT_STORES
    asm volatile("global_store_dwordx4 %0, %1, %2 sc1\n\ts_nop 1" :: "v"(off), "v"(v), "s"(base) : "memory");
#else
    *(GAS u32x4*)((GAS char*)base + off) = v;
#endif
}
__device__ __forceinline__ void stg_u2(void* base, unsigned off, u32x2 v) {
#if PROBE_NOSTORE
    if (base == nullptr) { asm volatile("" :: "v"(v)); return; }
#endif
    *(GAS u32x2*)((GAS char*)base + off) = v; }
__device__ __forceinline__ float ldg_f1(const void* base, unsigned off) { return *(const GAS float*)((const GAS char*)base + off); }
__device__ __forceinline__ void stg_f1(void* base, unsigned off, float v) { *(GAS float*)((GAS char*)base + off) = v; }
__device__ __forceinline__ float red4(float s, int lane) {
    (void)lane;
    { auto r = __builtin_amdgcn_permlane16_swap(__float_as_uint(s), __float_as_uint(s), false, false); s = __uint_as_float(r[0]) + __uint_as_float(r[1]); }
    { auto r = __builtin_amdgcn_permlane32_swap(__float_as_uint(s), __float_as_uint(s), false, false); s = __uint_as_float(r[0]) + __uint_as_float(r[1]); }
    return s; }
__device__ __forceinline__ void stg_line_pair(void* base, unsigned roA, unsigned rowb, const u32x4 w0, const u32x4 w1, bool odd) {
    u32x4 a, b;
#pragma unroll
    for (int c = 0; c < 4; ++c) { const unsigned p1 = (unsigned)__builtin_amdgcn_update_dpp(0, (int)w1[c], 0xB1, 0xF, 0xF, false), p0 = (unsigned)__builtin_amdgcn_update_dpp(0, (int)w0[c], 0xB1, 0xF, 0xF, false);
        a[c] = odd ? p1 : w0[c]; b[c] = odd ? w1[c] : p0; }
    stg_u4(base, roA, a); stg_u4(base, roA + rowb, b);
}
struct ActP { float A, B, M0, M1; };
template <bool SIG> __device__ __forceinline__ float act_g(float x, const ActP& p) {
    const float ml = p.M1 * x + p.M0;
    if (!SIG) return ml;
    return ml * __builtin_amdgcn_rcpf(1.f + __builtin_amdgcn_exp2f(x * (p.A * (x * x) + p.B)));
}
template <bool SIG> __device__ __forceinline__ void epi_act_store(const f32x4 (&acc)[2][2][4][2], const float (&rs)[2][4], const f32x4 (&bv)[2][2], unsigned char* ws, unsigned off0, unsigned rowstep, const ActP p) {
#pragma unroll
    for (int ai = 0; ai < 2; ++ai)
#pragma unroll
        for (int m = 0; m < 4; ++m) { const unsigned ro = off0 + (unsigned)(ai * 8 + m) * rowstep; const float r = rs[ai][m];
#pragma unroll
            for (int bj = 0; bj < 2; ++bj) { const f32x4 v0 = acc[ai][bj][m][0] * r + bv[bj][0], v1 = acc[ai][bj][m][1] * r + bv[bj][1];
                u32x4 w; w.x = cvtpk_h(act_g<SIG>(v0[0], p), act_g<SIG>(v0[1], p)); w.y = cvtpk_h(act_g<SIG>(v0[2], p), act_g<SIG>(v0[3], p));
                w.z = cvtpk_h(act_g<SIG>(v1[0], p), act_g<SIG>(v1[1], p)); w.w = cvtpk_h(act_g<SIG>(v1[2], p), act_g<SIG>(v1[3], p));
                stg_u4(ws, ro + 64u * bj, w); }
            asm volatile("" ::: "memory"); }
}

struct EpiIn {
    unsigned shw_off  ; const float* gq; const float* gk; const float* bg; unsigned char* ws_; unsigned char* wst_  ; const LAS float* ropel;
    __device__ __forceinline__ void operator()(const f32x4 (&acc)[2][2][4][2], const pg8::Unit& u, int wr, int wc, int fr, int fq) const {
        const int s = u.pn * 4 + wc;
        if (s >= 53) return;
        unsigned char* ws = ws_; asm volatile("" : "+s"(ws)); unsigned char* wst = wst_ ? ws : nullptr;
        const bool lat = u.pm < 128; const int b = lat ? (u.pm >> 3) : (u.pm - 128); const int bb = lat ? b : 16;
        const int rloc = wr * 64 + fr;
        const unsigned rbase = (unsigned)u.pm * 256u + (unsigned)rloc;
        float rs[2][4];
        { float t[2][4][4];
#pragma unroll
          for (int ai = 0; ai < 2; ++ai)
#pragma unroll
            for (int m = 0; m < 4; ++m)
#pragma unroll
              for (int j = 0; j < 4; ++j) t[ai][m][j] = ldg_f1(ws, (unsigned)WS_ROWSQ + ((unsigned)(4 * fq + j) * (unsigned)MROWS + rbase + ai * 128 + m * 16) * 4u);
#pragma unroll
          for (int ai = 0; ai < 2; ++ai)
#pragma unroll
            for (int m = 0; m < 4; ++m) rs[ai][m] = __builtin_amdgcn_rsqf(red4((t[ai][m][0] + t[ai][m][1]) + (t[ai][m][2] + t[ai][m][3]), fq * 16 + fr) * (1.f / 1024.f) + EPS); }
        const bool mapA = s >= 12 && s <= 21;
        f32x4 bv[2][2];
#pragma unroll
        for (int bj = 0; bj < 2; ++bj)
#pragma unroll
            for (int n = 0; n < 2; ++n) bv[bj][n] = ldg_f4(ws, shw_off + (unsigned)(bb * NPAD + u.pn * 256 + 128 * bj + 32 * wc + 16 * n + 4 * fq) * 4u);
        const int key0 = lat ? CTXL + (u.pm & 7) * 256 : 0;
        if (s < 12 || s >= 22) {
            if (s == 52) {
                if (fq < 2) { const f32x4 g0 = *(const GAS f32x4*)(bg + 8 * fq), g1 = *(const GAS f32x4*)(bg + 8 * fq + 4);
#pragma unroll
                    for (int ai = 0; ai < 2; ++ai)
#pragma unroll
                        for (int m = 0; m < 4; ++m) { const float r = rs[ai][m]; const f32x4 vi = acc[ai][0][m][0] * r + bv[0][0] + g0; f32x4 vf = acc[ai][0][m][1] * r + bv[0][1] + g1;
                            vf = (f32x4){logsigf(vf[0]), logsigf(vf[1]), logsigf(vf[2]), logsigf(vf[3])};
                            const unsigned go = (unsigned)WS_G + (rbase + ai * 128 + m * 16) * 64u + 32u * fq; stg_f4(wst, go, vi); stg_f4(wst, go + 16u, vf); } }
                return;
            }
            unsigned base, pitch, coff; int act; unsigned row0 = (unsigned)u.pm * 256u;
            if (s < 4) { base = (unsigned)WS_GU; pitch = 256; coff = s * 64; act = 1; }
            else if (s < 8) { base = (unsigned)WS_VN; pitch = 256; coff = (s - 4) * 64; act = 1; }
            else if (s < 12) { base = (unsigned)WS_SZ; pitch = 256; coff = (s - 8) * 64; act = 2; }
            else if (s < 24) { base = (unsigned)WS_VB; pitch = 64; coff = 0; act = 0; row0 = (unsigned)(b * 2 + (s - 22)) * NKEY + key0; }
            else if (s < 32) { base = (unsigned)WS_BZ; pitch = 512; coff = (s - 24) * 64; act = 2; }
            else if (s < 36) { base = (unsigned)WS_CQ; pitch = 256; coff = (s - 32) * 64; act = 0; }
            else if (s < 40) { base = (unsigned)WS_CK; pitch = 256; coff = (s - 36) * 64; act = 4; }
            else if (s < 44) { base = (unsigned)WS_CV; pitch = 256; coff = (s - 40) * 64; act = 0; }
            else if (s < 48) { base = (unsigned)WS_CO; pitch = 256; coff = (s - 44) * 64; act = 3; }
            else { base = (unsigned)WS_CZ; pitch = 256; coff = (s - 48) * 64; act = 2; }
            const unsigned off0 = base + ((row0 + rloc) * pitch + coff + 8u * fq) * 2u, rowstep = 32u * pitch;
            (void)act;
            if (act == 4) {
#pragma unroll
                for (int ai = 0; ai < 2; ++ai)
#pragma unroll
                    for (int m = 0; m < 4; ++m) rs[ai][m] *= 0.125f;
#pragma unroll
                for (int bj = 0; bj < 2; ++bj)
#pragma unroll
                    for (int n = 0; n < 2; ++n) bv[bj][n] *= 0.125f; }
            const bool odd = (fr & 1) != 0;
            const unsigned offA = base + ((row0 + (unsigned)(wr * 64 + (fr & ~1))) * pitch + coff) * 2u + (odd ? 64u : 0u) + 16u * fq;
#pragma unroll
            for (int ai = 0; ai < 2; ++ai)
#pragma unroll
                for (int m = 0; m < 4; ++m) { const unsigned ro = offA + (unsigned)(ai * 8 + m) * rowstep; const float r = rs[ai][m];
                    u32x4 w[2];
#pragma unroll
                    for (int bj = 0; bj < 2; ++bj) { const f32x4 v0 = acc[ai][bj][m][0] * r + bv[bj][0], v1 = acc[ai][bj][m][1] * r + bv[bj][1];
                        w[bj].x = cvtpk_h(v0[0], v0[1]); w[bj].y = cvtpk_h(v0[2], v0[3]); w[bj].z = cvtpk_h(v1[0], v1[1]); w[bj].w = cvtpk_h(v1[2], v1[3]); }
                    stg_line_pair(wst, ro, 2u * pitch, w[0], w[1], odd);
                    asm volatile("" ::: "memory"); }
            return;
        }
        const bool isq = s < 20; const float* gv = isq ? gq : gk; const float osc = isq ? QSCALE : 1.f;
        f32x4 g4[2][2];
#pragma unroll
        for (int bj = 0; bj < 2; ++bj)
#pragma unroll
            for (int n = 0; n < 2; ++n) g4[bj][n] = *(const GAS f32x4*)(gv + 32 * bj + 16 * n + 4 * fq) * osc;
        const unsigned pitch = isq ? 512u : 64u;
        const bool odd = (fr & 1) != 0; const unsigned rpair = (unsigned)(wr * 64 + (fr & ~1)), cb = (odd ? 64u : 0u) + 16u * fq;
        const unsigned offA = isq ? (unsigned)WS_Q + (((unsigned)u.pm * 256u + rpair) * 512u + (s - 12) * 64) * 2u + cb
                                  : (unsigned)WS_KB + (((unsigned)(b * 2 + (s - 20)) * NKEY + key0 + rpair) * 64u) * 2u + cb;
#pragma unroll
        for (int ai = 0; ai < 2; ++ai)
#pragma unroll
            for (int m = 0; m < 4; ++m) { const float r = rs[ai][m]; f32x4 v[2][2]; float ss = 0.f;
#pragma unroll
                for (int bj = 0; bj < 2; ++bj)
#pragma unroll
                    for (int n = 0; n < 2; ++n) { v[bj][n] = acc[ai][bj][m][n] * r + bv[bj][n]; ss += (v[bj][n][0] * v[bj][n][0] + v[bj][n][1] * v[bj][n][1]) + (v[bj][n][2] * v[bj][n][2] + v[bj][n][3] * v[bj][n][3]); }
                const float rn = __builtin_amdgcn_rsqf(red4(ss, fq * 16 + fr) * (1.f / 64.f) + EPS);
#pragma unroll
                for (int bj = 0; bj < 2; ++bj)
#pragma unroll
                    for (int n = 0; n < 2; ++n) v[bj][n] = v[bj][n] * rn * g4[bj][n];
                if (lat) { const unsigned t = (rbase + ai * 128 + m * 16) & (SEQ - 1);
#pragma unroll
                    for (int bj = 0; bj < 2; ++bj) { const unsigned pos = bj ? (t & 63u) : (t >> 6); const f32x4 cs = *(const LAS f32x4*)(ropel + pos * 16u + 4u * fq), sn = *(const LAS f32x4*)(ropel + 1024u + pos * 16u + 4u * fq);
                        const f32x4 x1 = v[bj][0], x2 = v[bj][1]; v[bj][0] = x1 * cs - x2 * sn; v[bj][1] = x2 * cs + x1 * sn; } }
                const unsigned ro = offA + (unsigned)(ai * 8 + m) * 32u * pitch;
                u32x4 w[2];
#pragma unroll
                for (int bj = 0; bj < 2; ++bj) { w[bj].x = cvtpk_h(v[bj][0][0], v[bj][0][1]); w[bj].y = cvtpk_h(v[bj][0][2], v[bj][0][3]); w[bj].z = cvtpk_h(v[bj][1][0], v[bj][1][1]); w[bj].w = cvtpk_h(v[bj][1][2], v[bj][1][3]); }
                stg_line_pair(wst, ro, 2u * pitch, w[0], w[1], odd);
                asm volatile("" ::: "memory"); }
    }
};

struct EpiOut {
    unsigned gt_off  ; unsigned an_off  ; unsigned char* ws_; float gscale; bool half  ;
    __device__ __forceinline__ void operator()(const f32x4 (&acc)[2][2][4][2], const pg8::Unit& u, int wr, int wc, int fr, int fq) const {
        unsigned char* ws = ws_; asm volatile("" : "+s"(ws));
        const bool lat = u.pm < 128; const int bb = lat ? (u.pm >> 3) : 16;
        const unsigned hmo = half ? (unsigned)u.hm * 128u : 0u; const unsigned rloc = hmo + wr * 64 + fr, col0 = u.pn * 256 + wc * 64 + 8 * fq;
        f32x4 g4[2][2], a4[2][2];
#pragma unroll
        for (int bj = 0; bj < 2; ++bj)
#pragma unroll
            for (int n = 0; n < 2; ++n) { g4[bj][n] = ldg_f4(ws, gt_off + ((unsigned)bb * 3072u + col0 + 32 * bj + 4 * n) * 4u) * gscale; a4[bj][n] = an_off ? ldg_f4(ws, an_off + ((unsigned)bb * 1024u + col0 + 32 * bj + 4 * n) * 4u) : (f32x4){0.f, 0.f, 0.f, 0.f}; }
        const unsigned rqo = (unsigned)WS_ROWSQ + ((unsigned)(u.pn * 4 + wc) * (unsigned)MROWS + (unsigned)u.pm * 256u + rloc) * 4u;
        const bool odd = (fr & 1) != 0;
        const unsigned eoA = (((unsigned)u.pm * 256u + hmo + (unsigned)(wr * 64 + (fr & ~1))) * D + u.pn * 256 + wc * 64) * 2u + (odd ? 64u : 0u) + 16u * fq;
#pragma unroll
        for (int ai = 0; ai < 2; ++ai)
#pragma unroll
            for (int m = 0; m < 4; ++m) { if (half && ai == 1) continue; const unsigned rr = (unsigned)(ai * 128 + m * 16); const unsigned o = eoA + rr * (D * 2u); float ss = 0.f;
                const u32x4 la = *(const GAS u32x4*)((const GAS char*)ws + (unsigned)WS_X16 + o), lb = *(const GAS u32x4*)((const GAS char*)ws + (unsigned)WS_X16 + o + D * 2u);
                u32x4 xr[2];
#pragma unroll
                for (int c = 0; c < 4; ++c) { const unsigned pa = (unsigned)__builtin_amdgcn_update_dpp(0, (int)la[c], 0xB1, 0xF, 0xF, false), pb = (unsigned)__builtin_amdgcn_update_dpp(0, (int)lb[c], 0xB1, 0xF, 0xF, false);
                    xr[0][c] = odd ? pb : la[c]; xr[1][c] = odd ? lb[c] : pa; }
                u32x4 w[2], v[2];
#pragma unroll
                for (int bj = 0; bj < 2; ++bj) { const h16x8 xb = __builtin_bit_cast(h16x8, xr[bj]);
                    const f32x4 x0 = (f32x4){(float)xb[0], (float)xb[1], (float)xb[2], (float)xb[3]} + g4[bj][0] * acc[ai][bj][m][0], x1 = (f32x4){(float)xb[4], (float)xb[5], (float)xb[6], (float)xb[7]} + g4[bj][1] * acc[ai][bj][m][1];
                    ss += ((x0[0] * x0[0] + x0[1] * x0[1]) + (x0[2] * x0[2] + x0[3] * x0[3])) + ((x1[0] * x1[0] + x1[1] * x1[1]) + (x1[2] * x1[2] + x1[3] * x1[3]));
                    w[bj].x = cvtpk_h(x0[0], x0[1]); w[bj].y = cvtpk_h(x0[2], x0[3]); w[bj].z = cvtpk_h(x1[0], x1[1]); w[bj].w = cvtpk_h(x1[2], x1[3]);
                    const f32x4 y0 = x0 * a4[bj][0], y1 = x1 * a4[bj][1]; v[bj].x = cvtpk_h(y0[0], y0[1]); v[bj].y = cvtpk_h(y0[2], y0[3]); v[bj].z = cvtpk_h(y1[0], y1[1]); v[bj].w = cvtpk_h(y1[2], y1[3]); }
                stg_line_pair(ws, (unsigned)WS_X16 + o, D * 2u, w[0], w[1], odd);
                if (an_off) stg_line_pair(ws, (unsigned)WS_XS + o, D * 2u, v[0], v[1], odd);
                ss = red4(ss, fq * 16 + fr); if (fq == 0) stg_f1(ws, rqo + rr * 4u, ss);
                if (m & 1) asm volatile("" ::: "memory"); }
    }
};
typedef GAS unsigned gu32;
#define RLX_AGENT __ATOMIC_RELAXED, __HIP_MEMORY_SCOPE_AGENT
#define LDS_WAIT() asm volatile("s_waitcnt lgkmcnt(0)" ::: "memory")
#define VM_WAIT() asm volatile("s_waitcnt vmcnt(0)" ::: "memory")
#define BAR_LDS() asm volatile("s_waitcnt lgkmcnt(0)\n\ts_barrier" ::: "memory")
constexpr int NWAVES = 8, NTHREADS = 512;
constexpr int RING_BYTES = 131072;
constexpr int MISC_OFF = RING_BYTES;
constexpr int ROPE_LDS_OFF = MISC_OFF + 1024;
constexpr int LDS_BYTES = 147456;

#define XB_TMO      128
#define XB_XCNT(j)  (256  + 64 * (j))
#define XB_XSUB(j)  (1280 + 64 * (j))
#define XB_XGEN(j)  (2304 + 64 * (j))
#define XB_TOP      3328
#define XB_TOPGEN   3392
#define XCD_BAR_WORDS 3456
#define XB_SPIN_CAP (1u << 20)
__device__ __forceinline__ unsigned xb_ld(unsigned* p)              { return __hip_atomic_load(p, __ATOMIC_RELAXED, __HIP_MEMORY_SCOPE_AGENT); }
__device__ __forceinline__ unsigned xb_add(unsigned* p, unsigned v) { return __hip_atomic_fetch_add(p, v, __ATOMIC_RELAXED, __HIP_MEMORY_SCOPE_AGENT); }
__device__ __forceinline__ unsigned xb_xcc_id() { return (unsigned)__builtin_amdgcn_s_getreg((3 << 11) | 20) & 0xFu; }
#define XB_SPIN(cond, bar) do { unsigned _sp = 0; while (cond) { __builtin_amdgcn_s_sleep(1); \
    if ((++_sp & 255u) == 0u) { if (xb_ld(&(bar)[XB_TMO])) break; if (_sp > XB_SPIN_CAP) { atomicAdd(&(bar)[XB_TMO], 1u); break; } } } } while (0)
struct XcdBarrier { unsigned* bar; unsigned x; volatile LAS unsigned* st; };
__device__ __forceinline__ XcdBarrier xcd_barrier_post(unsigned* bar, volatile LAS unsigned* st) {
    XcdBarrier b; b.bar = bar; b.x = xb_xcc_id(); b.st = st;
    if (threadIdx.x == 0) (void)xb_add(&bar[XB_XCNT(b.x)], 1u);
    return b;
}
__device__ __forceinline__ void xcd_barrier_complete(unsigned* bar, unsigned x, unsigned& nloc, unsigned& nx) {
    const unsigned G = gridDim.x * gridDim.y * gridDim.z;
    unsigned sum, cnt, mine, sp = 0u;
    for (;;) {
        sum = 0u; cnt = 0u; mine = 0u;
#pragma unroll
        for (unsigned j = 0; j < 16; ++j) { const unsigned c = xb_ld(&bar[XB_XCNT(j)]); sum += c; cnt += (c > 0u) ? 1u : 0u; mine = (j == x) ? c : mine; }
        if (sum == G) break;
        __builtin_amdgcn_s_sleep(1);
        if ((++sp & 255u) == 0u) { if (xb_ld(&bar[XB_TMO])) break; if (sp > XB_SPIN_CAP) { atomicAdd(&bar[XB_TMO], 1u); break; } }
    }
    nloc = mine > 0u ? mine : 1u; nx = cnt > 0u ? cnt : 1u;
}
__device__ __forceinline__ void xcd_barrier(const XcdBarrier& b) {
    asm volatile("s_waitcnt vmcnt(0)" ::: "memory");
    __syncthreads();
    if (threadIdx.x == 0) {
        unsigned* bar = b.bar;
        __builtin_amdgcn_s_waitcnt(0);
        unsigned nloc = b.st[0], nx = b.st[1];
        if (nloc == 0u) { xcd_barrier_complete(bar, b.x, nloc, nx); b.st[0] = nloc; b.st[1] = nx; }
        const unsigned old = xb_add(&bar[XB_XSUB(b.x)], 1u);
        const unsigned gen = old / nloc;
        if (old + 1u == (gen + 1u) * nloc) {
            __builtin_amdgcn_fence(__ATOMIC_RELEASE, "agent");
            asm volatile("s_waitcnt vmcnt(0)" ::: "memory");
            const unsigned og = xb_add(&bar[XB_TOP], 1u);
            const unsigned tg = og / nx;
            if (og + 1u == (tg + 1u) * nx) xb_add(&bar[XB_TOPGEN], 1u);
            else XB_SPIN(xb_ld(&bar[XB_TOPGEN]) == tg, bar);
            __builtin_amdgcn_fence(__ATOMIC_ACQUIRE, "agent");
            xb_add(&bar[XB_XGEN(b.x)], 1u);
            asm volatile("s_waitcnt vmcnt(0)" ::: "memory");
        } else {
            XB_SPIN(xb_ld(&bar[XB_XGEN(b.x)]) == gen, bar);
            __builtin_amdgcn_fence(__ATOMIC_ACQUIRE, "agent");
            asm volatile("s_waitcnt vmcnt(0)" ::: "memory");
        }
    }
    __syncthreads();
}

struct Frame { LAS unsigned char* lds; gu32* ctl; int tid, lane, wave, G, bid; Ptrs p; };

template <bool INPROJ> __device__ __forceinline__ void p0_transpose_item(const float* W, int N  , h16* WT, LAS float* scr, int item, int lane) {
    constexpr int K = 1024; const int nblk = (INPROJ ? NPAD : 1024) / 32, kb = item / nblk, nb = item % nblk, k0 = 64 * kb, n0 = 32 * nb;
    const int nn = n0 + (lane & 31); const bool valid = nn < N;
    float wv[32];
#pragma unroll
    for (int i = 0; i < 32; ++i) { const int kk = 2 * i + (lane >> 5); wv[i] = valid ? *(const GAS float*)(W + (size_t)(k0 + kk) * N + nn) : 0.f; }
#pragma unroll
    for (int i = 0; i < 32; ++i) { const int kk = 2 * i + (lane >> 5); scr[kk * 33 + (lane & 31)] = wv[i]; }
    LDS_WAIT(); asm volatile("" ::: "memory");
    const int c = lane & 7;
#pragma unroll
    for (int j = 0; j < 4; ++j) { const int n = (lane >> 3) + 8 * j; const LAS float* s = scr + (8 * c) * 33 + n;
        u32x4 o; o.x = cvtpk_h(s[0 * 33], s[1 * 33]); o.y = cvtpk_h(s[2 * 33], s[3 * 33]); o.z = cvtpk_h(s[4 * 33], s[5 * 33]); o.w = cvtpk_h(s[6 * 33], s[7 * 33]);
        const int col = n0 + n, pn = col >> 8, ca = col & 255; const bool mapA = INPROJ && slab_is_mapA(col >> 6);
        const int row = pn * 256 + tile_pos_of_col(ca, mapA);
        *(GAS u32x4*)(WT + (size_t)row * K + k0 + 8 * c) = o; }
    LDS_WAIT(); asm volatile("" ::: "memory");
}
__device__ __forceinline__ void skinny_item(Frame& F, const LAS float* AL, LAS float* RED, const float* W, int ldw, int nvalid, int n0, const float* bias, float* out, int ldo) {
    const int lane = F.tid & 63, wv = F.tid >> 6, cq = lane & 15, kg = wv * 4 + (lane >> 4); const int n = n0 + 4 * cq; const bool valid = n < nvalid;
    f32x4 acc[17];
#pragma unroll
    for (int i = 0; i < 17; ++i) acc[i] = (f32x4){0.f, 0.f, 0.f, 0.f};
    const float* wp = W + (size_t)(kg * 32) * ldw + (valid ? n : 0);
#pragma unroll 1
    for (int k = 0; k < 32; k += 8) {
        f32x4 w[8];
#pragma unroll
        for (int j = 0; j < 8; ++j) w[j] = valid ? *(const GAS f32x4*)(wp + (size_t)(k + j) * ldw) : (f32x4){0.f, 0.f, 0.f, 0.f};
#pragma unroll
        for (int q = 0; q < 2; ++q)
#pragma unroll
            for (int i = 0; i < 17; ++i) { const f32x4 a = *(const LAS f32x4*)(AL + i * 1024 + kg * 32 + k + 4 * q); acc[i] += (w[4 * q] * a[0] + w[4 * q + 1] * a[1]) + (w[4 * q + 2] * a[2] + w[4 * q + 3] * a[3]); }
    }
#pragma unroll
    for (int i = 0; i < 17; ++i)
#pragma unroll
        for (int c = 0; c < 4; ++c) { float v = acc[i][c]; v += lx_xor(v, 16, lane); v += lx_xor(v, 32, lane); acc[i][c] = v; }
    if (lane < 16) {
#pragma unroll
        for (int i = 0; i < 17; ++i) *(LAS f32x4*)(RED + (wv * 17 + i) * 64 + 4 * cq) = acc[i]; }
    __syncthreads();
    for (int o = F.tid; o < 17 * 64; o += NTHREADS) { const int i = o >> 6, c2 = o & 63; float s = 0.f;
#pragma unroll
        for (int g = 0; g < 8; ++g) s += RED[(g * 17 + i) * 64 + c2];
        const int nn = n0 + c2; if (nn < ldo) out[(size_t)i * ldo + nn] = (nn < nvalid) ? s + (bias ? bias[nn] : 0.f) : 0.f; }
    __syncthreads();
}
template <bool INPROJ> __device__ __forceinline__ void p0_transpose_tile(Frame& F, const float* W, int N  , h16* WT, int item) {
    constexpr int K = 1024, LS = 257; const int ntile = (INPROJ ? NPAD : 1024) / 256, kb = item / ntile, nt = item % ntile, k0 = 64 * kb, n0 = 256 * nt;
    LAS float* T = (LAS float*)F.lds; const int nn = n0 + 4 * F.lane; const bool valid = nn < N;
    f32x4 wv[8];
#pragma unroll
    for (int j = 0; j < 8; ++j) wv[j] = valid ? *(const GAS f32x4*)(W + (size_t)(k0 + 8 * F.wave + j) * N + nn) : (f32x4){0.f, 0.f, 0.f, 0.f};
#pragma unroll
    for (int j = 0; j < 8; ++j) { LAS float* t = T + (8 * F.wave + j) * LS + 4 * F.lane; t[0] = wv[j][0]; t[1] = wv[j][1]; t[2] = wv[j][2]; t[3] = wv[j][3]; }
    __syncthreads();
    const int c = F.lane & 7;
#pragma unroll
    for (int ps = 0; ps < 4; ++ps) { const int n = 32 * F.wave + 8 * ps + (F.lane >> 3); const LAS float* s = T + (8 * c) * LS + n;
        u32x4 o; o.x = cvtpk_h(s[0 * LS], s[1 * LS]); o.y = cvtpk_h(s[2 * LS], s[3 * LS]); o.z = cvtpk_h(s[4 * LS], s[5 * LS]); o.w = cvtpk_h(s[6 * LS], s[7 * LS]);
        const int col = n0 + n, ca = col & 255; const bool mapA = INPROJ && slab_is_mapA(col >> 6);
        *(GAS u32x4*)(WT + (size_t)(nt * 256 + tile_pos_of_col(ca, mapA)) * K + k0 + 8 * c) = o; }
    __syncthreads();
}
__device__ __forceinline__ void p0ab(Frame& F) {
    const Ptrs& p = F.p; unsigned char* ws = p.ws;
    { constexpr int I_IN = 16 * (NPAD / 256), I_OUT = 16 * 4, NIT = DEPTH * (I_IN + I_OUT);
      for (int it = F.bid; it < NIT; it += F.G) { const int l = it / (I_IN + I_OUT), r = it % (I_IN + I_OUT);
          if (r < I_IN) p0_transpose_tile<true>(F, p.win + (size_t)l * D * DIN, DIN, (h16*)(ws + WS_WINT) + (size_t)l * NPAD * D, r);
          else p0_transpose_tile<false>(F, p.wout + (size_t)l * D * D, D, (h16*)(ws + WS_WOT) + (size_t)l * D * D, r - I_IN); }
      const int gt = F.bid * NTHREADS + F.tid;
      for (int i = gt; i < DEPTH * 4 * 128 * 128 / 4; i += F.G * NTHREADS) { const f32x4 v = ((const f32x4*)p.wsp)[i]; u32x2 w; w.x = cvtpk_h(v[0], v[1]); w.y = cvtpk_h(v[2], v[3]); ((u32x2*)(ws + WS_WS16))[i] = w; }
      if (F.bid == 1 && F.tid < 64 * DEPTH) { const int l = F.tid >> 6, d = F.lane; float a = fabsf(p.gq[l * 64 + d]), b2 = fabsf(p.gk[l * 64 + d]);
#pragma unroll
          for (int o = 1; o < 64; o <<= 1) { a = fmaxf(a, lx_xor(a, o, d)); b2 = fmaxf(b2, lx_xor(b2, o, d)); }
          if (d == 0) ((float*)(ws + WS_ROPE))[2048 + l] = 8.f * 1.4426950408889634f * a * b2 - 15.f; }
      if (F.bid == 0) { float* rope = (float*)(ws + WS_ROPE); for (int i = F.tid; i < 1024; i += NTHREADS) { const int pos = i >> 4, fi = i & 15; const float freq = exp2f(-(float)fi * (13.287712379549449f / 16.f)); const float rev = (float)pos * freq * 0.15915494309189535f;
          const float fr_ = rev - floorf(rev); rope[i] = __builtin_amdgcn_cosf(fr_); rope[1024 + i] = __builtin_amdgcn_sinf(fr_); } }
    }
    __syncthreads();
    { LAS float* AL = (LAS float*)F.lds; LAS float* RED = AL + 17 * 1024; bool loaded = false;
      for (int it = F.bid; it < DEPTH * 48; it += F.G) {
          if (!loaded) { f32x4 tv[9];
#pragma unroll
              for (int j = 0; j < 9; ++j) { const int i = F.tid + NTHREADS * j, bb = i >> 8, k4 = i & 255; const float* src = bb < 16 ? p.c + bb * D : p.cctx; tv[j] = (j < 8 || F.tid < 256) ? *(const GAS f32x4*)(src + 4 * k4) : (f32x4){0.f, 0.f, 0.f, 0.f}; }
#pragma unroll
              for (int j = 0; j < 9; ++j) { const int i = F.tid + NTHREADS * j; if (j < 8 || F.tid < 256) *(LAS f32x4*)(AL + 4 * i) = (f32x4){siluf(tv[j][0]), siluf(tv[j][1]), siluf(tv[j][2]), siluf(tv[j][3])}; }
              __syncthreads(); loaded = true; }
          const int l = it / 48, nb = it % 48;
          skinny_item(F, AL, RED, p.wada + (size_t)l * D * 3072, 3072, 3072, nb * 64, p.bada + l * 3072, (float*)(ws + WS_MOD) + (size_t)l * 17 * 3072, 3072); }
    }
}
__device__ __forceinline__ void p0c(Frame& F) {
    const Ptrs& p = F.p; unsigned char* ws = p.ws; const float* MOD = (const float*)(ws + WS_MOD);
    { LAS h16* AH = (LAS h16*)F.lds; LAS float* RED = (LAS float*)(F.lds + 32 * 1032 * 2); int loaded = -1; const int r32 = F.lane & 31, kh = F.lane >> 5;
      for (int it = F.bid; it < DEPTH * 56; it += F.G) { const int l = it / 56, nb = it % 56;
          if (loaded != l) { __syncthreads();
              { f32x4 tv[9];
#pragma unroll
                for (int j = 0; j < 9; ++j) { const int i = F.tid + NTHREADS * j, bb = i >> 8, k4 = i & 255; tv[j] = (j < 8 || F.tid < 256) ? *(const GAS f32x4*)(MOD + ((size_t)l * 17 + bb) * 3072 + 4 * k4) : (f32x4){0.f, 0.f, 0.f, 0.f}; }
#pragma unroll
                for (int j = 0; j < 9; ++j) { const int i = F.tid + NTHREADS * j, bb = i >> 8, k4 = i & 255; if (j < 8 || F.tid < 256) { u32x2 w; w.x = cvtpk_h(tv[j][0], tv[j][1]); w.y = cvtpk_h(tv[j][2], tv[j][3]); *(LAS u32x2*)(AH + bb * 1032 + 4 * k4) = w; } }
                for (int i = F.tid; i < 15 * 256; i += NTHREADS) *(LAS u32x2*)(AH + (17 + (i >> 8)) * 1032 + 4 * (i & 255)) = (u32x2){0u, 0u}; }
              __syncthreads(); loaded = l; }
          const h16* WT = (const h16*)(ws + WS_WINT) + ((size_t)l * NPAD + nb * 64) * D;
          h16x8 bf[2][8];
#pragma unroll
          for (int nbk = 0; nbk < 2; ++nbk)
#pragma unroll
              for (int ks = 0; ks < 8; ++ks) bf[nbk][ks] = *(const GAS h16x8*)(WT + (size_t)(32 * nbk + r32) * D + 128 * F.wave + 16 * ks + 8 * kh);
          f32x16 acc[2]; acc[0] = f32x16{}; acc[1] = f32x16{};
#pragma unroll
          for (int ks = 0; ks < 8; ++ks) { const h16x8 af = *(const LAS h16x8*)(AH + r32 * 1032 + 128 * F.wave + 16 * ks + 8 * kh);
              acc[0] = __builtin_amdgcn_mfma_f32_32x32x16_f16(af, bf[0][ks], acc[0], 0, 0, 0); acc[1] = __builtin_amdgcn_mfma_f32_32x32x16_f16(af, bf[1][ks], acc[1], 0, 0, 0); }
#pragma unroll
          for (int nbk = 0; nbk < 2; ++nbk)
#pragma unroll
              for (int r = 0; r < 16; ++r) { const int bb = (r & 3) + 8 * (r >> 2) + 4 * kh; if (bb < 17) RED[(F.wave * 17 + bb) * 64 + 32 * nbk + r32] = acc[nbk][r]; }
          __syncthreads();
          for (int o = F.tid; o < 17 * 64; o += NTHREADS) { const int bb = o >> 6, c2 = o & 63; float s = 0.f;
#pragma unroll
              for (int g = 0; g < 8; ++g) s += RED[(g * 17 + bb) * 64 + c2];
              ((float*)(ws + WS_SHW))[((size_t)l * 17 + bb) * NPAD + nb * 64 + c2] = s; }
          __syncthreads(); }
    }
    { float* AM = (float*)(ws + WS_AMOD); const int gt = F.bid * NTHREADS + F.tid;
      for (int i = gt; i < DEPTH * 17 * 1024; i += F.G * NTHREADS) { const int k = i & 1023, lb = i >> 10, l = lb / 17; AM[i] = p.gnorm[l * D + k] * (1.f + MOD[(size_t)lb * 3072 + 1024 + k]); } }
    { const int gw = F.bid * NWAVES + F.wave, NGW = F.G * NWAVES; h16* XS = (h16*)(ws + WS_XS); h16* X16 = (h16*)(ws + WS_X16); float* RQ = (float*)(ws + WS_ROWSQ);
      for (int r0 = gw; r0 < MROWS; r0 += 2 * NGW) {
          f32x4 xv[2][2][2]; int rr[2]; bool ok[2];
#pragma unroll
          for (int q = 0; q < 2; ++q) { rr[q] = r0 + q * NGW; ok[q] = rr[q] < MROWS; const int r = ok[q] ? rr[q] : gw; const float* xr = r < MLAT ? p.x + (size_t)r * D : p.ctx + (size_t)(r - MLAT) * D;
#pragma unroll
              for (int j = 0; j < 2; ++j) { const int k = j * 512 + F.lane * 8; xv[q][j][0] = *(const GAS f32x4*)(xr + k); xv[q][j][1] = *(const GAS f32x4*)(xr + k + 4); } }
#pragma unroll
          for (int q = 0; q < 2; ++q) { const int r = ok[q] ? rr[q] : gw; const int bb = r < MLAT ? (r >> 11) : 16; const float* mod = MOD + (size_t)bb * 3072 + 1024; float ss = 0.f;
#pragma unroll
              for (int j = 0; j < 2; ++j) { const int k = j * 512 + F.lane * 8; u32x4 wx, wy;
#pragma unroll
                  for (int hh = 0; hh < 2; ++hh) { const f32x4 v = xv[q][j][hh], g = *(const GAS f32x4*)(p.gnorm + k + 4 * hh), s1 = *(const GAS f32x4*)(mod + k + 4 * hh);
                      ss += (v[0] * v[0] + v[1] * v[1]) + (v[2] * v[2] + v[3] * v[3]); const f32x4 y = v * (g * (s1 + 1.f));
                      if (hh == 0) { wy.x = cvtpk_h(y[0], y[1]); wy.y = cvtpk_h(y[2], y[3]); wx.x = cvtpk_h(v[0], v[1]); wx.y = cvtpk_h(v[2], v[3]); } else { wy.z = cvtpk_h(y[0], y[1]); wy.w = cvtpk_h(y[2], y[3]); wx.z = cvtpk_h(v[0], v[1]); wx.w = cvtpk_h(v[2], v[3]); } }
                  if (ok[q]) { *(GAS u32x4*)(XS + (size_t)r * D + k) = wy; *(GAS u32x4*)(X16 + (size_t)r * D + k) = wx; } }
#pragma unroll
              for (int o = 1; o < 64; o <<= 1) ss += lx_xor(ss, o, F.lane);
              if (ok[q] && F.lane == 0) *(GAS float*)(RQ + r) = ss; } }
      const int gt = F.bid * NTHREADS + F.tid;
      for (int i = gt; i < 15 * MROWS / 4; i += F.G * NTHREADS) *(GAS f32x4*)(RQ + MROWS + 4 * (size_t)i) = (f32x4){0.f, 0.f, 0.f, 0.f};
    }
}
__device__ __forceinline__ void p_final(Frame& F) {
    const Ptrs& p = F.p; const float* RQ = (const float*)(p.ws + WS_ROWSQ); const h16* X16 = (const h16*)(p.ws + WS_X16); const int gw = F.bid * NWAVES + F.wave, NGW = F.G * NWAVES;
    f32x4 gf[4];
#pragma unroll
    for (int j = 0; j < 4; ++j) gf[j] = *(const GAS f32x4*)(p.gfinal + j * 256 + F.lane * 4);
    for (int grp = gw; grp < MLAT / 16; grp += NGW) { const int rowb = grp * 16;
        f32x4 qs = *(const GAS f32x4*)(RQ + (size_t)(F.lane >> 2) * MROWS + rowb + 4 * (F.lane & 3));
#pragma unroll
        for (int c = 0; c < 4; ++c) { float v = qs[c];
            v += __int_as_float(__builtin_amdgcn_update_dpp(0, __float_as_int(v), 0x124, 0xF, 0xF, false)); v += __int_as_float(__builtin_amdgcn_update_dpp(0, __float_as_int(v), 0x128, 0xF, 0xF, false));
            { auto r = __builtin_amdgcn_permlane16_swap(__float_as_uint(v), __float_as_uint(v), false, false); v = __uint_as_float(r[0]) + __uint_as_float(r[1]); }
            { auto r = __builtin_amdgcn_permlane32_swap(__float_as_uint(v), __float_as_uint(v), false, false); v = __uint_as_float(r[0]) + __uint_as_float(r[1]); }
            qs[c] = __builtin_amdgcn_rsqf(v * (1.f / 1024.f) + EPS); }
#pragma unroll
        for (int trip = 0; trip < 4; ++trip) {
            h16x4 xv[4][4];
#pragma unroll
            for (int t = 0; t < 4; ++t)
#pragma unroll
                for (int j = 0; j < 4; ++j) xv[t][j] = *(const GAS h16x4*)(X16 + (size_t)(rowb + 4 * trip + t) * D + j * 256 + F.lane * 4);
#pragma unroll
            for (int t = 0; t < 4; ++t) { const float rs = lx_get(qs[t], trip); float* orow = p.out + (size_t)(rowb + 4 * trip + t) * D;
#pragma unroll
                for (int j = 0; j < 4; ++j) { const h16x4 v = xv[t][j];
                    *(GAS f32x4*)(orow + j * 256 + F.lane * 4) = (f32x4){(float)v[0], (float)v[1], (float)v[2], (float)v[3]} * rs * gf[j]; } } }
    }
}
namespace attn_body {
typedef short s16x8 __attribute__((ext_vector_type(8)));
#define H8(x) __builtin_bit_cast(h16x8, (x))
constexpr int NW = 8, QBLK = 32, QB = QBLK * NW, KVBLK = 64;
constexpr int QP = 512, KP = 64, YP = 1024, ZP = 512;
__device__ __forceinline__ int crow(int r, int hi) { return (r & 3) + 8 * (r >> 2) + 4 * hi; }
#define SBAR() __builtin_amdgcn_sched_barrier(0)
constexpr int NSLOT = 3, SLOTB = 8192;
constexpr int LDS_K = 0, LDS_V = NSLOT * SLOTB, LDS_WS = 2 * NSLOT * SLOTB, LDS_OST = LDS_WS + NW * 64 * 4, ATT_LDS_BYTES = LDS_OST + NW * 4096, LDS_QN = 90112  ;
struct Seam { int o_attn, o_attc, o_gmlp; const h16 *Q, *KB, *VB; volatile LAS int* slot; };
__device__ __forceinline__ void glds16(const void* gsrc, unsigned lds_dst) { unsigned keep;
  asm volatile("s_mov_b32 %0, m0\n\ts_mov_b32 m0, %2\n\ts_nop 0\n\tglobal_load_lds_dwordx4 %1, off\n\ts_mov_b32 m0, %0" : "=&s"(keep) : "v"(gsrc), "s"(lds_dst) : "memory"); }
__device__ __forceinline__ float max3f(float a, float b, float c) { float r; asm("v_max3_f32 %0, %1, %2, %3" : "=v"(r) : "v"(a), "v"(b), "v"(c)); return r; }
__device__ __forceinline__ float max2f(float a, float b) { float r; asm("v_max_f32_e32 %0, %1, %2" : "=v"(r) : "v"(a), "v"(b)); return r; }
__device__ __forceinline__ float fadd_s(float a, float b) { float r; asm("v_add_f32_e32 %0, %1, %2" : "=v"(r) : "v"(a), "v"(b)); return r; }
__device__ __forceinline__ float fsub_s(float a, float b) { float r; asm("v_sub_f32_e32 %0, %1, %2" : "=v"(r) : "v"(a), "v"(b)); return r; }
#define WAIT_BAR(N) asm volatile("s_waitcnt vmcnt(" #N ") lgkmcnt(0)\n\ts_barrier" ::: "memory")
__device__ __forceinline__ void qkt(f32x16& p0, f32x16& p1, const char* Kslot, const s16x8* qr, const f32x16& negm, int r32, int hi) {
  const char* kb = Kslot + hi * 1024 + r32 * 16;
#pragma unroll
  for (int d0 = 0; d0 < 4; ++d0) {
    const s16x8 b0 = *reinterpret_cast<const s16x8*>(kb + d0 * 2048);
    const s16x8 b1 = *reinterpret_cast<const s16x8*>(kb + d0 * 2048 + 512);
    if (d0 == 0) { p0 = __builtin_amdgcn_mfma_f32_32x32x16_f16(H8(b0), H8(qr[0]), negm, 0, 0, 0); p1 = __builtin_amdgcn_mfma_f32_32x32x16_f16(H8(b1), H8(qr[0]), negm, 0, 0, 0); }
    else { p0 = __builtin_amdgcn_mfma_f32_32x32x16_f16(H8(b0), H8(qr[d0]), p0, 0, 0, 0); p1 = __builtin_amdgcn_mfma_f32_32x32x16_f16(H8(b1), H8(qr[d0]), p1, 0, 0, 0); } }
}
typedef LAS const char* lds_cptr;
__device__ __forceinline__ void kload8(s16x8* kf, lds_cptr kp) {
  kf[0] = *(const LAS s16x8*)(kp);        kf[1] = *(const LAS s16x8*)(kp + 512);
  kf[2] = *(const LAS s16x8*)(kp + 2048); kf[3] = *(const LAS s16x8*)(kp + 2560);
  kf[4] = *(const LAS s16x8*)(kp + 4096); kf[5] = *(const LAS s16x8*)(kp + 4608);
  kf[6] = *(const LAS s16x8*)(kp + 6144); kf[7] = *(const LAS s16x8*)(kp + 6656);
}
__device__ __forceinline__ void kload2(s16x8* kf, lds_cptr kp, int j) { kf[2 * j] = *(const LAS s16x8*)(kp + j * 2048); kf[2 * j + 1] = *(const LAS s16x8*)(kp + j * 2048 + 512); }
__device__ __forceinline__ s16x4 vtr(lds_cptr p) { return __builtin_bit_cast(s16x4, __builtin_amdgcn_ds_read_tr16_b64_v4i16((LAS v4i16_t*)p)); }
__device__ __forceinline__ float rowmax(const f32x16& p0, const f32x16& p1) {
  float a = max3f(p0[0], p0[1], p1[0]), b = max3f(p0[2], p0[3], p1[1]); a = max3f(a, p1[2], p1[3]);
#pragma unroll
  for (int r = 4; r < 16; r += 4) { a = max3f(a, p0[r], p0[r + 1]); b = max3f(b, p0[r + 2], p0[r + 3]); a = max3f(a, p1[r], p1[r + 1]); b = max3f(b, p1[r + 2], p1[r + 3]); }
  const float m = max2f(a, b);
  auto rr = __builtin_amdgcn_permlane32_swap(__float_as_uint(m), __float_as_uint(m), false, false);
  return max2f(__uint_as_float(rr[0]), __uint_as_float(rr[1]));
}
__device__ __forceinline__ void pv(f32x16* o, int vb, s16x8 pa0, s16x8 pa1, s16x8 pa2, s16x8 pa3) {
#pragma unroll
  for (int d0 = 0; d0 < 2; ++d0) { s16x4 lo[4], hi[4];
#pragma unroll
    for (int ks = 0; ks < 4; ++ks) {
      asm volatile("ds_read_b64_tr_b16 %0,%1 offset:%c2" : "=&v"(lo[ks]) : "v"(vb), "i"(d0 * 4096 + ks * 1024) : "memory");
      asm volatile("ds_read_b64_tr_b16 %0,%1 offset:%c2" : "=&v"(hi[ks]) : "v"(vb), "i"(d0 * 4096 + ks * 1024 + 512) : "memory"); }
    asm volatile("s_waitcnt lgkmcnt(0)" ::: "memory"); SBAR();
#define PK(k) (s16x8){lo[k][0], lo[k][1], lo[k][2], lo[k][3], hi[k][0], hi[k][1], hi[k][2], hi[k][3]}
    o[d0] = __builtin_amdgcn_mfma_f32_32x32x16_f16(H8(pa0), H8(PK(0)), o[d0], 0, 0, 0);
    o[d0] = __builtin_amdgcn_mfma_f32_32x32x16_f16(H8(pa1), H8(PK(1)), o[d0], 0, 0, 0);
    o[d0] = __builtin_amdgcn_mfma_f32_32x32x16_f16(H8(pa2), H8(PK(2)), o[d0], 0, 0, 0);
    o[d0] = __builtin_amdgcn_mfma_f32_32x32x16_f16(H8(pa3), H8(PK(3)), o[d0], 0, 0, 0);
#undef PK
  }
}
template <int THRL, bool FIXM> __device__ __forceinline__ bool attn_unit(const h16* Qrows, const h16* __restrict__ Kh, const h16* __restrict__ Vh, const int NT, h16* Yrows, const h16* BZrows, char* shm, const int tid, const float mfix,
                                                                        const bool warm, const unsigned nxt_t0, const Seam sm) {
  const int lane = tid & 63, r32 = lane & 31, hi = lane >> 5; const int wid = __builtin_amdgcn_readfirstlane(tid >> 6);
  const h16* Qw = Qrows + (long)(wid * QBLK) * QP;
  const unsigned lds0 = (unsigned)(uintptr_t)shm;
  float* wsf = (float*)(shm + LDS_WS) + wid * 64;
  const h16* ksrc = Kh + (long)lane * KP + wid * 8;
  const h16* vsrc = Vh + (long)(16 * (wid & 3) + (lane >> 2)) * KP + (wid >> 2) * 32 + (lane & 3) * 8;
  const unsigned kdst = lds0 + LDS_K + wid * 1024, vdst = lds0 + LDS_V + wid * 1024;
#define DMA_K(t, slot) glds16(ksrc + (long)(t) * KVBLK * KP, (unsigned)__builtin_amdgcn_readfirstlane(kdst + (slot)))
#define DMA_V(t, slot) glds16(vsrc + (long)(t) * KVBLK * KP, (unsigned)__builtin_amdgcn_readfirstlane(vdst + (slot)))
  const int vb0 = (int)(lds0 + LDS_V) + ((lane >> 4) & 1) * 32 + (lane & 3) * 8 + (4 * hi + ((lane & 15) >> 2)) * 64;
  const char* Kbase = shm + LDS_K; s16x8 kf[8];
  const lds_cptr shm3 = (lds_cptr)shm; const lds_cptr kp0 = shm3 + LDS_K + hi * 1024 + r32 * 16; const lds_cptr vp0 = shm3 + LDS_V + ((lane >> 4) & 1) * 32 + (lane & 3) * 8 + (4 * hi + ((lane & 15) >> 2)) * 64;
  if (!warm) { DMA_K(0, 0); DMA_V(0, 0); DMA_K(1, SLOTB); }
  s16x8 qr[4];
#pragma unroll
  for (int d0 = 0; d0 < 4; ++d0) qr[d0] = warm ? s16x8{} : *(const GAS s16x8*)(Qw + (long)r32 * QP + d0 * 16 + hi * 8);
  float mhat = 0.f, l_reg = 0.f; f32x16 o[2]; o[0] = f32x16{}; o[1] = f32x16{}; f32x16 negm = f32x16{}; asm volatile("" : "+v"(negm));
  bool resc = false;
#define START(P0, P1) do { const float rm = FIXM ? mfix : rowmax(P0, P1); resc = false; \
    { const float dl = rm; mhat = fadd_s(mhat, dl); \
      _Pragma("unroll") for (int r = 0; r < 16; ++r) { P0[r] = fsub_s(P0[r], dl); P1[r] = fsub_s(P1[r], dl); } \
      _Pragma("unroll") for (int r = 0; r < 16; ++r) negm[r] = -mhat; asm volatile("" : "+v"(negm)); } \
    _Pragma("unroll") for (int r = 0; r < 16; ++r) P0[r] = __builtin_amdgcn_exp2f(P0[r]); } while (0)
#define RESC() do { if (!FIXM && resc) { asm volatile("s_waitcnt lgkmcnt(0)" ::: "memory"); \
      _Pragma("unroll") for (int d_ = 0; d_ < 2; ++d_) _Pragma("unroll") for (int r = 0; r < 16; ++r) o[d_][r] *= wsf[crow(r, hi)]; } } while (0)
  f32x16 pA0, pA1, pB0, pB1;
  int sl_prev = 0, sl_cur = 0, sl_next = SLOTB;
#define ROT() do { sl_prev = sl_cur; sl_cur = sl_next; sl_next = (sl_next == (NSLOT - 1) * SLOTB) ? 0 : sl_next + SLOTB; } while (0)
  if (!warm) { DMA_K(2, 2 * SLOTB); WAIT_BAR(3); }
  else { asm volatile("s_waitcnt vmcnt(4) lgkmcnt(0)\n\ts_barrier" ::: "memory");
#pragma unroll
      for (int d0 = 0; d0 < 4; ++d0) qr[d0] = *(const LAS s16x8*)((lds_cptr)shm + LDS_QN + wid * 4096 + (2 * d0 + hi) * 512 + r32 * 16); }
  qkt(pA0, pA1, Kbase, qr, negm, r32, hi); asm volatile("s_nop 15\n\ts_nop 7" : "+v"(pA0), "+v"(pA1));
  START(pA0, pA1);
  _Pragma("unroll") for (int r = 0; r < 16; ++r) pA1[r] = __builtin_amdgcn_exp2f(pA1[r]);
  if (!warm) WAIT_BAR(0); else WAIT_BAR(4);
  DMA_K(3, 0); DMA_V(1, SLOTB);
  ROT();
  kload8(kf, kp0 + sl_cur);
  WAIT_BAR(2);
  s16x4 vlo[8], vhi[8]; u32x4 pw0, pw1, pw2, pw3;
#define PKW(P, B) cvtpk_h(P[B], P[B + 1])
#define PAF(k) __builtin_bit_cast(h16x8, pw##k)
#define VFR(i) H8(((s16x8){vlo[i][0], vlo[i][1], vlo[i][2], vlo[i][3], vhi[i][0], vhi[i][1], vhi[i][2], vhi[i][3]}))
#define PIN(x) asm volatile("" : "+v"(x))
#define MX3(a, b, c) __builtin_fmaxf(__builtin_fmaxf((a), (b)), (c))
#define GAPA(MF, A0, A1, A2, A3, W0, W1, PW) do { MF; sacc += A0; sacc += A1; sacc += A2; sacc += A3; PIN(sacc); W0; W1; PIN(PW); SBAR(); } while (0)
#define EX(v) __builtin_amdgcn_exp2f(v)
#define GAPB(MF, X, B) do { MF; X[B] = EX(X[B]); X[B + 1] = EX(X[B + 1]); X[B + 2] = EX(X[B + 2]); X[B + 3] = EX(X[B + 3]); PIN(X); SBAR(); } while (0)
#define VRD(i) do { vlo[i] = vtr(vp_ + (((i) >> 2) * 4096 + ((i) & 3) * 1024)); vhi[i] = vtr(vp_ + (((i) >> 2) * 4096 + ((i) & 3) * 1024 + 512)); } while (0)
#define KRD(G, j) do { if (G) { kload2(kf, kp0 + sl_next, j); SBAR(); } } while (0)
#define QK(kfi, qri, C) __builtin_amdgcn_mfma_f32_32x32x16_f16(H8(kf[kfi]), H8(qr[qri]), C, 0, 0, 0)
#define STEP(C0, C1, P0, P1, t, GK, GV, GL) do { SBAR(); \
    const lds_cptr vp_ = vp0 + sl_prev; \
    VRD(0); SBAR(); float sacc = (P0[0] + P0[1]); \
    GAPA(C0 = QK(0, 0, negm), P0[2], P0[3], P0[4], P0[5],     pw0[0] = PKW(P0, 0), pw0[1] = PKW(P0, 2), pw0); \
    VRD(4); SBAR(); GAPA(C1 = QK(1, 0, negm), P0[6], P0[7], P0[8], P0[9],     pw0[2] = PKW(P0, 4), pw0[3] = PKW(P0, 6), pw0); \
    VRD(1); SBAR(); GAPA(C0 = QK(2, 1, C0),   P0[10], P0[11], P0[12], P0[13], pw1[0] = PKW(P0, 8), pw1[1] = PKW(P0, 10), pw1); \
    VRD(5); SBAR(); GAPA(C1 = QK(3, 1, C1),   P0[14], P0[15], P1[0], P1[1],   pw1[2] = PKW(P0, 12), pw1[3] = PKW(P0, 14), pw1); \
    VRD(2); SBAR(); GAPA(C0 = QK(4, 2, C0),   P1[2], P1[3], P1[4], P1[5],     pw2[0] = PKW(P1, 0), pw2[1] = PKW(P1, 2), pw2); \
    VRD(6); SBAR(); GAPA(C1 = QK(5, 2, C1),   P1[6], P1[7], P1[8], P1[9],     pw2[2] = PKW(P1, 4), pw2[3] = PKW(P1, 6), pw2); \
    VRD(3); SBAR(); GAPA(C0 = QK(6, 3, C0),   P1[10], P1[11], P1[12], P1[13], pw3[0] = PKW(P1, 8), pw3[1] = PKW(P1, 10), pw3); \
    VRD(7); SBAR(); GAPA(C1 = QK(7, 3, C1),   P1[14], P1[15], 0.f, 0.f,       pw3[2] = PKW(P1, 12), pw3[3] = PKW(P1, 14), pw3); \
    l_reg += sacc; \
    if (GK) { DMA_K((t) + 3, sl_cur); } if (GV) { DMA_V((t) + 1, sl_next); } \
    if (!FIXM) { float a = MX3(C0[0], C0[1], C1[0]), b = MX3(C0[2], C0[3], C1[1]); a = MX3(a, C1[2], C1[3]); \
      _Pragma("unroll") for (int r = 4; r < 16; r += 4) { a = MX3(a, C0[r], C0[r + 1]); b = MX3(b, C0[r + 2], C0[r + 3]); a = MX3(a, C1[r], C1[r + 1]); b = MX3(b, C1[r + 2], C1[r + 3]); } \
      float rm = __builtin_fmaxf(a, b); { auto rr = __builtin_amdgcn_permlane32_swap(__float_as_uint(rm), __float_as_uint(rm), false, false); rm = __builtin_fmaxf(__uint_as_float(rr[0]), __uint_as_float(rr[1])); } \
      resc = false; \
      if (__builtin_expect(__any(rm > (float)THRL), 0)) { const float dl = __builtin_fmaxf(rm, 0.f); mhat += dl; \
        _Pragma("unroll") for (int r = 0; r < 16; ++r) { C0[r] -= dl; C1[r] -= dl; } \
        _Pragma("unroll") for (int r = 0; r < 16; ++r) negm[r] = -mhat; asm volatile("" : "+v"(negm)); \
        const float f = __builtin_amdgcn_exp2f(-dl); l_reg *= f; if (hi == 0) wsf[r32] = f; resc = true; } } \
    SBAR(); \
    GAPB(o[0] = __builtin_amdgcn_mfma_f32_32x32x16_f16(PAF(0), VFR(0), o[0], 0, 0, 0), C0, 0); \
    GAPB(o[1] = __builtin_amdgcn_mfma_f32_32x32x16_f16(PAF(0), VFR(4), o[1], 0, 0, 0), C0, 4); \
    KRD(GL, 0); GAPB(o[0] = __builtin_amdgcn_mfma_f32_32x32x16_f16(PAF(1), VFR(1), o[0], 0, 0, 0), C0, 8); \
    KRD(GL, 1); GAPB(o[1] = __builtin_amdgcn_mfma_f32_32x32x16_f16(PAF(1), VFR(5), o[1], 0, 0, 0), C0, 12); \
    KRD(GL, 2); GAPB(o[0] = __builtin_amdgcn_mfma_f32_32x32x16_f16(PAF(2), VFR(2), o[0], 0, 0, 0), C1, 0); \
    KRD(GL, 3); GAPB(o[1] = __builtin_amdgcn_mfma_f32_32x32x16_f16(PAF(2), VFR(6), o[1], 0, 0, 0), C1, 4); \
    GAPB(o[0] = __builtin_amdgcn_mfma_f32_32x32x16_f16(PAF(3), VFR(3), o[0], 0, 0, 0), C1, 8); \
    GAPB(o[1] = __builtin_amdgcn_mfma_f32_32x32x16_f16(PAF(3), VFR(7), o[1], 0, 0, 0), C1, 12); \
    } while (0)
  int t = 1;
  for (; t + 5 < NT; t += 2) {
    STEP(pB0, pB1, pA0, pA1, t, true, true, true);     WAIT_BAR(2); RESC(); ROT();
    STEP(pA0, pA1, pB0, pB1, t + 1, true, true, true); WAIT_BAR(2); RESC(); ROT();
  }
#define ENDW(tt) do { if ((tt) + 3 < NT) { WAIT_BAR(2); } else if ((tt) + 2 < NT) { WAIT_BAR(1); } else { WAIT_BAR(0); } } while (0)
  const bool can_seam = NT > 8;
  if (can_seam && tid == 0) *sm.slot = (int)nxt_t0;
  for (; t + 1 < NT; t += 2) {
    STEP(pB0, pB1, pA0, pA1, t, (t + 3 < NT), (t + 1 < NT), (t + 1 < NT));         ENDW(t);     RESC(); ROT();
    STEP(pA0, pA1, pB0, pB1, t + 1, (t + 4 < NT), (t + 2 < NT), (t + 2 < NT));     ENDW(t + 1); RESC(); ROT();
  }
  bool warm_next = false;
  if (can_seam) { const int un = __builtin_amdgcn_readfirstlane(*sm.slot);
    if (un >= sm.o_attn && un < sm.o_gmlp) { const bool isl = un < sm.o_attc; const int a = isl ? un - sm.o_attn : un - sm.o_attc;
      const int qb = isl ? (a & 7) : 0, g = isl ? (a >> 3) : a, hq = g & 3, kvh = (g >> 2) & 1, b = g >> 3, h = kvh * 4 + hq;
      const long row0 = isl ? (long)b * SEQ + qb * 256 : (long)MLAT + (long)b * CTXL; const long kvo = ((long)(b * 2 + kvh) * NKEY) * 64;
      const h16* Qn = sm.Q + row0 * 512 + h * 64 + (long)(wid * QBLK + r32) * QP + hi * 8; const h16* ksn = sm.KB + kvo + (long)lane * KP + wid * 8;
      const h16* vsn = sm.VB + kvo + (long)(16 * (wid & 3) + (lane >> 2)) * KP + (wid >> 2) * 32 + (lane & 3) * 8;
      glds16(ksn, (unsigned)__builtin_amdgcn_readfirstlane(kdst)); glds16(vsn, (unsigned)__builtin_amdgcn_readfirstlane(vdst)); glds16(ksn + (long)KVBLK * KP, (unsigned)__builtin_amdgcn_readfirstlane(kdst + SLOTB));
      glds16(ksn + (long)2 * KVBLK * KP, (unsigned)__builtin_amdgcn_readfirstlane(kdst + 2 * SLOTB));
#pragma unroll
      for (int i = 0; i < 4; ++i) glds16(Qn + 16 * i, (unsigned)__builtin_amdgcn_readfirstlane(lds0 + LDS_QN + wid * 4096 + i * 1024));
      warm_next = true; } }
  STEP(pB0, pB1, pA0, pA1, NT - 1, false, false, false); RESC();
  { float sacc = pB0[0] + pB0[1]; _Pragma("unroll") for (int r = 2; r < 16; ++r) sacc += pB0[r]; _Pragma("unroll") for (int r = 0; r < 16; ++r) sacc += pB1[r]; l_reg += sacc;
    pw0 = (u32x4){PKW(pB0, 0), PKW(pB0, 2), PKW(pB0, 4), PKW(pB0, 6)}; pw1 = (u32x4){PKW(pB0, 8), PKW(pB0, 10), PKW(pB0, 12), PKW(pB0, 14)}; pw2 = (u32x4){PKW(pB1, 0), PKW(pB1, 2), PKW(pB1, 4), PKW(pB1, 6)}; pw3 = (u32x4){PKW(pB1, 8), PKW(pB1, 10), PKW(pB1, 12), PKW(pB1, 14)};
    SBAR(); pv(o, vb0 + sl_cur, __builtin_bit_cast(s16x8, pw0), __builtin_bit_cast(s16x8, pw1), __builtin_bit_cast(s16x8, pw2), __builtin_bit_cast(s16x8, pw3)); }
  h16x8 zg[4];
  { const h16* Zw0 = BZrows + (long)(wid * QBLK) * ZP;
#pragma unroll
    for (int i = 0; i < 4; ++i) zg[i] = *(const GAS h16x8*)(Zw0 + (long)(i * 8 + (lane >> 3)) * ZP + (lane & 7) * 8); }
#undef PKW
#undef PAF
#undef VFR
#undef PIN
#undef MX3
#undef GAPA
#undef GAPB
#undef EX
#undef VRD
#undef KRD
#undef QK
#undef STEP
#undef ENDW
  { auto rr = __builtin_amdgcn_permlane32_swap(__float_as_uint(l_reg), __float_as_uint(l_reg), false, false); l_reg = __uint_as_float(rr[0]) + __uint_as_float(rr[1]); }
  if (hi == 0) wsf[32 + r32] = l_reg; asm volatile("s_waitcnt lgkmcnt(0)" ::: "memory");
  float rli[16];
#pragma unroll
  for (int r = 0; r < 16; ++r) rli[r] = __builtin_amdgcn_rcpf(wsf[32 + crow(r, hi)]);
  h16* Yw = Yrows + (long)(wid * QBLK) * YP;
  { h16* stg = (h16*)(shm + LDS_OST) + wid * 2048;
#pragma unroll
    for (int r = 0; r < 16; ++r) { const int orow = crow(r, hi);
#pragma unroll
      for (int d0 = 0; d0 < 2; ++d0) stg[orow * 64 + d0 * 32 + r32] = (h16)(o[d0][r] * rli[r]); }
    asm volatile("s_waitcnt lgkmcnt(0)" ::: "memory");
#pragma unroll
    for (int i = 0; i < 4; ++i) { const int row = i * 8 + (lane >> 3), ch = lane & 7; const h16x8 v = *(const h16x8*)(stg + row * 64 + ch * 8); const h16x8 z = zg[i];
      u32x4 w; w.x = cvtpk_h((float)v[0] * siluf((float)z[0]), (float)v[1] * siluf((float)z[1])); w.y = cvtpk_h((float)v[2] * siluf((float)z[2]), (float)v[3] * siluf((float)z[3]));
      w.z = cvtpk_h((float)v[4] * siluf((float)z[4]), (float)v[5] * siluf((float)z[5])); w.w = cvtpk_h((float)v[6] * siluf((float)z[6]), (float)v[7] * siluf((float)z[7]));
      *(GAS u32x4*)(Yw + (long)row * YP + ch * 8) = w; } }
  asm volatile("s_waitcnt lgkmcnt(0)\n\ts_barrier" ::: "memory");
#undef DMA_K
#undef DMA_V
#undef START
#undef RESC
#undef ROT
  return warm_next;
}
#undef SBAR
#undef WAIT_BAR
}

namespace mx {
using attn_body::s16x8; using attn_body::crow;
#define H8(x) __builtin_bit_cast(h16x8, (x))
constexpr float LOG2E = 1.4426950408889634f;
__device__ __forceinline__ s16x8 tr_frag(LAS const char* img, int half_bytes, int nb, int ks, int lane) {
    LAS const char* p = img + nb * half_bytes + (16 * ks + 8 * (lane >> 5) + ((lane & 15) >> 2)) * 64 + (16 * ((lane >> 4) & 1) + 4 * (lane & 3)) * 2;
    const s16x4 lo = __builtin_bit_cast(s16x4, __builtin_amdgcn_ds_read_tr16_b64_v4i16((LAS v4i16_t*)p));
    const s16x4 hi = __builtin_bit_cast(s16x4, __builtin_amdgcn_ds_read_tr16_b64_v4i16((LAS v4i16_t*)(p + 256)));
    return (s16x8){lo[0], lo[1], lo[2], lo[3], hi[0], hi[1], hi[2], hi[3]};
}
__device__ __forceinline__ float wave_incl_sum(float v, int lane) {
#pragma unroll
    for (int o = 1; o < 64; o <<= 1) { const float t = lx_up(v, o, lane); if (lane >= o) v += t; }
    return v;
}
__device__ __forceinline__ float wave_incl_max(float v, int lane) {
#pragma unroll
    for (int o = 1; o < 64; o <<= 1) { const float t = lx_up(v, o, lane); if (lane >= o) v = fmaxf(v, t); }
    return v;
}
struct GateRaw { float li0, lf0, li1, lf1; };
__device__ __forceinline__ GateRaw gate_load(const float* G, size_t rb, int h, int dir, int lane) {
    const int p0 = 2 * lane, t0 = dir ? 127 - p0 : p0, t1 = dir ? t0 - 1 : t0 + 1; GateRaw r;
    r.li0 = *(const GAS float*)(G + (rb + t0) * 16 + dir * 8 + h); r.lf0 = *(const GAS float*)(G + (rb + t0) * 16 + dir * 8 + 4 + h);
    r.li1 = *(const GAS float*)(G + (rb + t1) * 16 + dir * 8 + h); r.lf1 = *(const GAS float*)(G + (rb + t1) * 16 + dir * 8 + 4 + h);
    return r;
}
__device__ __forceinline__ void gate_compute(const GateRaw& r, int dir, float m0, LAS float* bL, LAS float* gL, LAS float* ML, int lane, float& Gmax, float& bend) {
    const int p0 = 2 * lane, t0 = dir ? 127 - p0 : p0, t1 = dir ? t0 - 1 : t0 + 1;
    const float incl = wave_incl_sum(r.lf0 + r.lf1, lane), excl = incl - (r.lf0 + r.lf1);
    const float b0 = excl + r.lf0, b1 = incl, g0 = r.li0 - b0, g1 = r.li1 - b1;
    const float gi = wave_incl_max(fmaxf(g0, g1), lane); float ge = lx_up(gi, 1, lane); if (lane == 0) ge = -INFINITY;
    const float G0 = fmaxf(ge, g0), G1 = gi;
    bL[t0] = b0; bL[t1] = b1; gL[t0] = g0; gL[t1] = g1; ML[t0] = fmaxf(m0, G0); ML[t1] = fmaxf(m0, G1);
    Gmax = lx_get(gi, 63); bend = lx_get(incl, 63);
}
__device__ __forceinline__ void gate_scan(const float* G, size_t rb, int h, int dir, float m0, LAS float* bL, LAS float* gL, LAS float* ML, int lane, float& Gmax, float& bend) {
    const GateRaw r = gate_load(G, rb, h, dir, lane); gate_compute(r, dir, m0, bL, gL, ML, lane, Gmax, bend);
}

constexpr int GM_SCR = 65536;
__device__ __forceinline__ void gmlp_unit(unsigned char* ws, h16* Y, const h16* Ws16  , const float* bs  , size_t r0, LAS unsigned char* lds, int tid) {
    const int lane = tid & 63, wid = __builtin_amdgcn_readfirstlane(tid >> 6), r32 = lane & 31, hi = lane >> 5;
    const h16* VN = (const h16*)(ws + WS_VN); const h16* GU = (const h16*)(ws + WS_GU); const h16* SZ = (const h16*)(ws + WS_SZ);
    const int g = wid >> 1, ph = wid & 1; const h16* Wg = Ws16 + (size_t)g * 128 * 128;
    u32x4 stg[8];
#pragma unroll
    for (int j = 0; j < 8; ++j) { const int i = tid + 512 * j, row = i >> 5, c8 = i & 31; stg[j] = *(const GAS u32x4*)(VN + (r0 + row) * 256 + c8 * 8); }
    s16x8 af[2][8];
#pragma unroll
    for (int q = 0; q < 2; ++q)
#pragma unroll
        for (int ks = 0; ks < 8; ++ks) af[q][ks] = *(const GAS s16x8*)(Wg + (size_t)(32 * (2 * ph + q) + r32) * 128 + 16 * ks + 8 * hi);
    const int erow = lane >> 3, ech = lane & 7;
    h16x8 gu[2][4], sz[2][4]; float bias[2][4];
#pragma unroll
    for (int q = 0; q < 2; ++q)
#pragma unroll
        for (int ps = 0; ps < 4; ++ps) { bias[q][ps] = *(const GAS float*)(bs + g * 128 + 32 * (2 * ph + q) + 8 * ps + erow);
            const size_t go = (r0 + 32 * (2 * ph + q) + 8 * ps + erow) * 256 + g * 64 + 8 * ech;
            gu[q][ps] = *(const GAS h16x8*)(GU + go); sz[q][ps] = *(const GAS h16x8*)(SZ + go); }
#pragma unroll
    for (int j = 0; j < 8; ++j) { const int i = tid + 512 * j, row = i >> 5, c8 = i & 31, gg = c8 >> 3, cg = (c8 & 7) * 8;
        const h16x8 hv = __builtin_bit_cast(h16x8, stg[j]); float x[8]; float sm = 0.f;
#pragma unroll
        for (int k = 0; k < 8; ++k) { x[k] = geluf((float)hv[k]); sm += x[k]; }
        sm += lx_xor(sm, 1, lane); sm += lx_xor(sm, 2, lane); sm += lx_xor(sm, 4, lane);
        const float mu = sm * (1.f / 64.f); float q = 0.f;
#pragma unroll
        for (int k = 0; k < 8; ++k) { x[k] -= mu; q += x[k] * x[k]; }
        q += lx_xor(q, 1, lane); q += lx_xor(q, 2, lane); q += lx_xor(q, 4, lane);
        const float rd = __builtin_amdgcn_rsqf(q * (1.f / 64.f) + EPS);
        u32x4 o; o.x = cvtpk_h(x[0] * rd, x[1] * rd); o.y = cvtpk_h(x[2] * rd, x[3] * rd); o.z = cvtpk_h(x[4] * rd, x[5] * rd); o.w = cvtpk_h(x[6] * rd, x[7] * rd);
        *(LAS u32x4*)(lds + gg * 16384 + (cg >> 5) * 8192 + row * 64 + (cg & 31) * 2) = o; }
    BAR_LDS();
    LAS h16* scr = (LAS h16*)(lds + GM_SCR) + wid * (32 * 72);
#pragma unroll
    for (int q = 0; q < 2; ++q) {
#pragma unroll
        for (int db = 0; db < 2; ++db) {
            s16x8 bf[8];
#pragma unroll
            for (int ks = 0; ks < 8; ++ks) bf[ks] = tr_frag((LAS const char*)lds + g * 16384, 8192, db, ks, lane);
            f32x16 acc = f32x16{};
#pragma unroll
            for (int ks = 0; ks < 8; ++ks) acc = __builtin_amdgcn_mfma_f32_32x32x16_f16(H8(af[q][ks]), H8(bf[ks]), acc, 0, 0, 0);
#pragma unroll
            for (int r = 0; r < 16; ++r) scr[crow(r, hi) * 72 + 32 * db + r32] = (h16)acc[r];
        }
        LDS_WAIT();
#pragma unroll
        for (int ps = 0; ps < 4; ++ps) { const int row = 8 * ps + erow;
            const h16x8 sv = *(const LAS h16x8*)(scr + row * 72 + 8 * ech);
            float y[8];
#pragma unroll
            for (int k = 0; k < 8; ++k) y[k] = geluf((float)gu[q][ps][k]) * ((float)sv[k] + bias[q][ps]) * siluf((float)sz[q][ps][k]);
            u32x4 w0; w0.x = cvtpk_h(y[0], y[1]); w0.y = cvtpk_h(y[2], y[3]); w0.z = cvtpk_h(y[4], y[5]); w0.w = cvtpk_h(y[6], y[7]);
            *(GAS u32x4*)(Y + (r0 + 32 * (2 * ph + q) + row) * D + g * 64 + 8 * ech) = w0; }
        LDS_WAIT();
    }
    BAR_LDS();
}

constexpr int SC_V = 0, SC_K = 32768, SC_WK = 65536, SC_GM = SC_WK + 18 * 512, SC_BE = SC_GM + 128, SC_TMP = SC_BE + 128, SC_CST = SC_TMP + 8 * 1536;
__device__ __forceinline__ size_t chunk_row0(int b, int dir, int ci) {
    if (ci < 2) return (size_t)MLAT + (size_t)b * CTXL + 128 * (dir ? 1 - ci : ci);
    return (size_t)b * SEQ + 128 * (dir ? 15 - (ci - 2) : ci - 2);
}
__device__ __forceinline__ unsigned char* state_ptr(unsigned char* ws, int b, int h, int dir, int ci) { return ws + WS_ST + (size_t)(((b * 4 + h) * 2 + dir) * NCHUNK + ci) * ST_STRIDE; }
__device__ __forceinline__ void scan_unit(unsigned char* ws, int b, int h, int dir, gu32* flag, LAS unsigned char* lds, int tid) {
    const int lane = tid & 63, wid = __builtin_amdgcn_readfirstlane(tid >> 6), r32 = lane & 31, hi = lane >> 5;
    const h16* CK = (const h16*)(ws + WS_CK); const h16* CV = (const h16*)(ws + WS_CV); const float* G = (const float*)(ws + WS_G);
    LAS float* WKA = (LAS float*)(lds + SC_WK); LAS float* GMA = (LAS float*)(lds + SC_GM); LAS float* BEA = (LAS float*)(lds + SC_BE);
    const int srow = tid >> 3, sc8 = tid & 7; const int soff = (sc8 >> 2) * 8192 + srow * 64 + (sc8 & 3) * 16;
    const size_t lofs = (size_t)srow * 256 + h * 64 + sc8 * 8;
    u32x4 kA[2], vA[2], kB[2], vB[2], kC[2], vC[2], kD[2], vD[2];
#define SC_LOAD(KR, VR, ci_) do { if ((ci_) < NCHUNK) { const size_t rb_ = chunk_row0(b, dir, (ci_)); _Pragma("unroll") for (int j = 0; j < 2; ++j) { \
        KR[j] = *(const GAS u32x4*)(CK + (rb_ + 64 * j) * 256 + lofs); VR[j] = *(const GAS u32x4*)(CV + (rb_ + 64 * j) * 256 + lofs); } } } while (0)
    SC_LOAD(kA, vA, 0); SC_LOAD(kB, vB, 1); SC_LOAD(kC, vC, 2); SC_LOAD(kD, vD, 3);
    { LAS float* tmpb = (LAS float*)(lds + SC_TMP) + wid * 384;
      GateRaw gr[3];
#pragma unroll
      for (int q = 0; q < 3; ++q) { const int ci = wid + 8 * q; gr[q] = GateRaw{0.f, 0.f, 0.f, 0.f}; if (ci < NCHUNK) gr[q] = gate_load(G, chunk_row0(b, dir, ci), h, dir, lane); }
#pragma unroll
      for (int q = 0; q < 3; ++q) { const int ci = wid + 8 * q; if (ci < NCHUNK) { float Gmax, bend; gate_compute(gr[q], dir, 0.f, tmpb, tmpb + 128, tmpb + 256, lane, Gmax, bend);
          LDS_WAIT();
          WKA[ci * 128 + lane] = __builtin_amdgcn_exp2f((tmpb[128 + lane] - Gmax) * LOG2E); WKA[ci * 128 + lane + 64] = __builtin_amdgcn_exp2f((tmpb[128 + lane + 64] - Gmax) * LOG2E);
          if (lane == 0) { GMA[ci] = Gmax; BEA[ci] = bend; } LDS_WAIT(); } } }
    BAR_LDS();
    f32x16 Cacc = f32x16{}; float nacc = 0.f; float m = 0.f;
    const int dblk = (wid >> 1) & 1, eblk = wid & 1;
#define SC_BODY(KR, VR, ci_) do { const int ci = (ci_); if (ci < NCHUNK) { \
        unsigned char* st = state_ptr(ws, b, h, dir, ci); const int buf = (ci & 1) * 16384; \
        _Pragma("unroll") for (int j = 0; j < 2; ++j) { *(LAS u32x4*)(lds + SC_V + buf + soff + j * 4096) = VR[j]; \
            const float w = WKA[ci * 128 + srow + 64 * j]; const h16x8 kv = __builtin_bit_cast(h16x8, KR[j]); u32x4 o; \
            o.x = cvtpk_h((float)kv[0] * w, (float)kv[1] * w); o.y = cvtpk_h((float)kv[2] * w, (float)kv[3] * w); o.z = cvtpk_h((float)kv[4] * w, (float)kv[5] * w); o.w = cvtpk_h((float)kv[6] * w, (float)kv[7] * w); \
            *(LAS u32x4*)(lds + SC_K + buf + soff + j * 4096) = o; } \
        SC_LOAD(KR, VR, ci + 4); \
        if (wid < 4) { LAS h16* cs = (LAS h16*)(lds + SC_CST + (ci & 1) * 8192); _Pragma("unroll") for (int r = 0; r < 16; ++r) cs[(32 * dblk + crow(r, hi)) * 64 + 32 * eblk + r32] = (h16)Cacc[r]; \
            if (wid < 2 && hi == 0) *(GAS float*)((float*)(st + 8192) + 32 * eblk + r32) = nacc; if (wid == 0 && lane == 0) *(GAS float*)(st + 8192 + 256) = m; } \
        BAR_LDS(); \
        *(GAS u32x4*)(st + tid * 16) = *(const LAS u32x4*)(lds + SC_CST + (ci & 1) * 8192 + tid * 16);     \
        const float Gmax = GMA[ci], bend = BEA[ci]; \
        const float Mend = fmaxf(m, Gmax), fd = __builtin_amdgcn_exp2f((m - Mend) * LOG2E), fu = __builtin_amdgcn_exp2f((Gmax - Mend) * LOG2E); \
        if (wid < 4) { f32x16 U = f32x16{}, U2 = f32x16{}; const s16x8 ones = (s16x8){0x3C00, 0x3C00, 0x3C00, 0x3C00, 0x3C00, 0x3C00, 0x3C00, 0x3C00}; \
            _Pragma("unroll") for (int ks = 0; ks < 8; ++ks) { const s16x8 a = tr_frag((LAS const char*)lds + SC_V + buf, 8192, dblk, ks, lane), bb = tr_frag((LAS const char*)lds + SC_K + buf, 8192, eblk, ks, lane); \
                U = __builtin_amdgcn_mfma_f32_32x32x16_f16(H8(a), H8(bb), U, 0, 0, 0); if (wid < 2) U2 = __builtin_amdgcn_mfma_f32_32x32x16_f16(H8(ones), H8(bb), U2, 0, 0, 0); }     \
            _Pragma("unroll") for (int r = 0; r < 16; ++r) Cacc[r] = fd * Cacc[r] + fu * U[r]; \
            if (wid < 2) nacc = fd * nacc + fu * U2[0]; } \
        m = bend + Mend; } } while (0)
#pragma unroll 1
    for (int c4 = 0; c4 < NCHUNK; c4 += 4) { SC_BODY(kA, vA, c4); SC_BODY(kB, vB, c4 + 1); SC_BODY(kC, vC, c4 + 2); SC_BODY(kD, vD, c4 + 3); }
#undef SC_BODY
#undef SC_LOAD
    VM_WAIT(); __syncthreads();
    if (tid == 0) { __builtin_amdgcn_fence(__ATOMIC_RELEASE, "agent"); VM_WAIT(); __hip_atomic_store(flag, 1u, RLX_AGENT); }
}

constexpr int MO_K = 0, MO_V = 16384, MO_GA = 32768, MO_N = 36864, MO_M0 = 37376, MO_WS = 37888, MO_OST = 40960  , MO_GH = 73728, MO_Q = 74752  , MO_CF = 91136  ;
struct MoutPre { u32x4 kv[2], vv[2], qv[2], cfv[2]; GateRaw graw; float m0g, nval; };
__device__ __forceinline__ size_t mout_rb(int b, int tc) { return tc < 2 ? (size_t)MLAT + (size_t)b * CTXL + 128 * tc : (size_t)b * SEQ + 128 * (tc - 2); }
__device__ __forceinline__ void mout_load(MoutPre& R, unsigned char* ws, int b, int h, int tc, int tid) {
    const int lane = tid & 63, wid = tid >> 6, r32 = lane & 31, hi = lane >> 5, dir = wid >> 2, wl = wid & 3;
    const h16* CQ = (const h16*)(ws + WS_CQ); const h16* CK = (const h16*)(ws + WS_CK); const h16* CV = (const h16*)(ws + WS_CV); const float* G = (const float*)(ws + WS_G);
    const size_t rb = mout_rb(b, tc);
#pragma unroll
    for (int j = 0; j < 2; ++j) { const int i = tid + 512 * j, row = i >> 3, c8 = i & 7; const size_t go = (rb + row) * 256 + h * 64 + c8 * 8;
        R.kv[j] = *(const GAS u32x4*)(CK + go); R.vv[j] = *(const GAS u32x4*)(CV + go); R.qv[j] = *(const GAS u32x4*)(CQ + go); }
    R.graw = GateRaw{0.f, 0.f, 0.f, 0.f}; if (wl == 0) R.graw = gate_load(G, rb, h, dir, lane);
}
__device__ __forceinline__ void mout_load_mn(MoutPre& R, unsigned char* ws, int b, int h, int tc, int tid) {
    const int lane = tid & 63, wid = tid >> 6, dir = wid >> 2, wl = wid & 3;
    const int ci = tc < 2 ? (dir ? 1 - tc : tc) : 2 + (dir ? 15 - (tc - 2) : tc - 2);
    const unsigned char* st = state_ptr(ws, b, h, dir, ci);
    R.m0g = 0.f; R.nval = 0.f; if (wl == 0) { R.m0g = *(const GAS float*)(st + 8192 + 256); R.nval = *(const GAS float*)((const float*)(st + 8192) + lane); }
#pragma unroll
    for (int d = 0; d < 2; ++d) { const int cd = tc < 2 ? (d ? 1 - tc : tc) : 2 + (d ? 15 - (tc - 2) : tc - 2); R.cfv[d] = *(const GAS u32x4*)(state_ptr(ws, b, h, d, cd) + tid * 16); }
}
__device__ __forceinline__ void mlstm_out_loop(unsigned char* ws, h16* Y, const float* ghead  , int u  , const int o_mout, const int o_end, const int ntc, const bool ctx_out,
                                               gu32* head, gu32* chain  , volatile LAS unsigned* acq, volatile LAS int* slot, LAS unsigned char* lds, char* shm, int tid) {
    const int lane = tid & 63, wid = __builtin_amdgcn_readfirstlane(tid >> 6), r32 = lane & 31, hi = lane >> 5, dir = wid >> 2, wl = wid & 3;
    int b, h, tc; { const int a = u - o_mout, tci = a % ntc, bh = a / ntc; b = bh >> 2; h = bh & 3; tc = ctx_out ? tci : tci + 2; }
    MoutPre R; mout_load(R, ws, b, h, tc, tid); bool have_mn = false;
    { LAS float* GH = (LAS float*)(lds + MO_GH); if (tid < 256) GH[tid] = *(const GAS float*)(ghead + tid); }
    unsigned tk = 0u; if (tid == 0) tk = __hip_atomic_fetch_add(head, 1u, RLX_AGENT);
    for (;;) {
        const unsigned nxt = tk; if (tid == 0) tk = __hip_atomic_fetch_add(head, 1u, RLX_AGENT);
        const size_t rb = mout_rb(b, tc);
        const int ci = tc < 2 ? (dir ? 1 - tc : tc) : 2 + (dir ? 15 - (tc - 2) : tc - 2);
        const unsigned char* st = state_ptr(ws, b, h, dir, ci);
        if (*acq == 0u) {
            __syncthreads();
            if (wid == 0) { unsigned sp = 0; for (;;) { const unsigned f0 = __hip_atomic_load(chain + 64 * lane, RLX_AGENT), f1 = __hip_atomic_load(chain + 64 * (lane + 64), RLX_AGENT);
                    if (__all(f0 != 0u && f1 != 0u)) break; __builtin_amdgcn_s_sleep(8); if (++sp > (1u << 20)) break; }
                __builtin_amdgcn_fence(__ATOMIC_ACQUIRE, "agent"); VM_WAIT(); if (lane == 0) *acq = 1u; }
            __syncthreads();
        }
        if (!have_mn) { mout_load_mn(R, ws, b, h, tc, tid); have_mn = true; }
        const float m0g = R.m0g, nval = R.nval;
#pragma unroll
        for (int j = 0; j < 2; ++j) { const int i = tid + 512 * j, row = i >> 3, c8 = i & 7, sl = row >> 6, r = row & 63;
            *(LAS u32x4*)(lds + MO_K + sl * 8192 + c8 * 1024 + r * 16) = R.kv[j];
            *(LAS u32x4*)(lds + MO_V + sl * 8192 + ((c8 >> 2) * 4 + (r >> 4)) * 1024 + (r & 15) * 64 + (c8 & 3) * 16) = R.vv[j];
            *(LAS u32x4*)(lds + MO_Q + c8 * 2048 + row * 16) = R.qv[j]; }
#pragma unroll
        for (int d = 0; d < 2; ++d) *(LAS u32x4*)(lds + MO_CF + d * 8192 + (tid & 7) * 1024 + (tid >> 3) * 16) = R.cfv[d];
        LAS float* bL = (LAS float*)(lds + MO_GA + dir * 1536); LAS float* gL = bL + 128; LAS float* ML = bL + 256; LAS float* NL = (LAS float*)(lds + MO_N + dir * 256); LAS float* M0 = (LAS float*)(lds + MO_M0);
        if (wl == 0) { float Gm, be; gate_compute(R.graw, dir, m0g, bL, gL, ML, lane, Gm, be); NL[lane] = nval; if (lane == 0) M0[dir] = m0g; }
        if (tid == 0) *slot = (int)nxt;
        BAR_LDS();
        const int un = __builtin_amdgcn_readfirstlane(*slot); const bool more = un < o_end;
        int nb = 0, nh = 0, ntcv = 0;
        if (more) { const int a = un - o_mout, tci = a % ntc, bh = a / ntc; nb = bh >> 2; nh = bh & 3; ntcv = ctx_out ? tci : tci + 2; mout_load(R, ws, nb, nh, ntcv, tid); mout_load_mn(R, ws, nb, nh, ntcv, tid); }
        const int frow = tid >> 3, fc8 = tid & 7; const size_t fgo = (rb + frow) * 256 + h * 64 + fc8 * 8;
        const h16x8 co0 = *(const GAS h16x8*)((const h16*)(ws + WS_CO) + fgo), co1 = *(const GAS h16x8*)((const h16*)(ws + WS_CO) + fgo + 64 * 256), cz0 = *(const GAS h16x8*)((const h16*)(ws + WS_CZ) + fgo), cz1 = *(const GAS h16x8*)((const h16*)(ws + WS_CZ) + fgo + 64 * 256);
        s16x8 qr[4], cf[4][2];
#pragma unroll
        for (int d0 = 0; d0 < 4; ++d0) qr[d0] = *(const LAS s16x8*)(lds + MO_Q + (2 * d0 + hi) * 2048 + (32 * wl + r32) * 16);
#pragma unroll
        for (int ks = 0; ks < 4; ++ks)
#pragma unroll
            for (int d0 = 0; d0 < 2; ++d0) cf[ks][d0] = *(const LAS s16x8*)(lds + MO_CF + dir * 8192 + (2 * ks + hi) * 1024 + (32 * d0 + r32) * 16);
        const int t = 32 * wl + r32;
        const float m0 = M0[dir], Mt = ML[t], bt = bL[t], inter = __builtin_amdgcn_exp2f((m0 - Mt) * LOG2E);
        f32x16 o[2]; o[0] = f32x16{}; o[1] = f32x16{}; float sacc = 0.f; const f32x16 zero16 = f32x16{};
        const unsigned lds0 = (unsigned)(uintptr_t)shm;
        { float dq = 0.f; const h16 ih = (h16)inter;
#pragma unroll
          for (int ks = 0; ks < 4; ++ks) { const h16x8 q8 = H8(qr[ks]); const f32x4 n0 = *(const LAS f32x4*)(NL + 16 * ks + 8 * hi), n1 = *(const LAS f32x4*)(NL + 16 * ks + 8 * hi + 4);
              dq += ((float)q8[0] * n0[0] + (float)q8[1] * n0[1]) + ((float)q8[2] * n0[2] + (float)q8[3] * n0[3]) + ((float)q8[4] * n1[0] + (float)q8[5] * n1[1]) + ((float)q8[6] * n1[2] + (float)q8[7] * n1[3]);
              const h16x8 qs = q8 * ih;
#pragma unroll
              for (int d0 = 0; d0 < 2; ++d0) o[d0] = __builtin_amdgcn_mfma_f32_32x32x16_f16(qs, H8(cf[ks][d0]), o[d0], 0, 0, 0); }
          sacc += inter * dq; }
#pragma unroll
        for (int kb = 0; kb < 2; ++kb) {
            const bool need = dir ? (kb == 1 || wl <= 1) : (kb == 0 || wl >= 2);
            if (need) {
                f32x16 p0, p1; attn_body::qkt(p0, p1, shm + MO_K + kb * 8192, qr, zero16, r32, hi);
#pragma unroll
                for (int i = 0; i < 4; ++i) { const f32x4 ga = *(const LAS f32x4*)(gL + 64 * kb + 8 * i + 4 * hi), gb = *(const LAS f32x4*)(gL + 64 * kb + 32 + 8 * i + 4 * hi);
#pragma unroll
                    for (int jj = 0; jj < 4; ++jj) { const int r = 4 * i + jj, s0 = 64 * kb + 8 * i + 4 * hi + jj, s1 = s0 + 32;
                        const bool k0 = dir ? (s0 >= t) : (s0 <= t), k1 = dir ? (s1 >= t) : (s1 <= t);
                        const float w0 = k0 ? p0[r] * __builtin_amdgcn_exp2f((ga[jj] - Mt) * LOG2E) : 0.f, w1 = k1 ? p1[r] * __builtin_amdgcn_exp2f((gb[jj] - Mt) * LOG2E) : 0.f;
                        p0[r] = w0; p1[r] = w1; sacc += w0 + w1; } }
                u32x4 pw0, pw1, pw2, pw3;
#define PKW(P, B) cvtpk_h(P[B], P[B + 1])
                pw0 = (u32x4){PKW(p0, 0), PKW(p0, 2), PKW(p0, 4), PKW(p0, 6)}; pw1 = (u32x4){PKW(p0, 8), PKW(p0, 10), PKW(p0, 12), PKW(p0, 14)};
                pw2 = (u32x4){PKW(p1, 0), PKW(p1, 2), PKW(p1, 4), PKW(p1, 6)}; pw3 = (u32x4){PKW(p1, 8), PKW(p1, 10), PKW(p1, 12), PKW(p1, 14)};
#undef PKW
                const int vb = (int)(lds0 + MO_V + kb * 8192) + ((lane >> 4) & 1) * 32 + (lane & 3) * 8 + (4 * hi + ((lane & 15) >> 2)) * 64;
                attn_body::pv(o, vb, __builtin_bit_cast(s16x8, pw0), __builtin_bit_cast(s16x8, pw1), __builtin_bit_cast(s16x8, pw2), __builtin_bit_cast(s16x8, pw3));
            }
        }
        { auto rr = __builtin_amdgcn_permlane32_swap(__float_as_uint(sacc), __float_as_uint(sacc), false, false); sacc = __uint_as_float(rr[0]) + __uint_as_float(rr[1]); }
        const float hden = fmaxf(fabsf(sacc), __builtin_amdgcn_exp2f(-(bt + Mt) * LOG2E));
        LAS float* wsf = (LAS float*)(lds + MO_WS) + wid * 64;
        if (hi == 0) wsf[r32] = __builtin_amdgcn_rcpf(hden);
        LDS_WAIT();
        LAS h16* ost = (LAS h16*)(lds + MO_OST) + wid * 2048;
#pragma unroll
        for (int r = 0; r < 16; ++r) { const int orow = crow(r, hi); const float rl = wsf[orow];
#pragma unroll
            for (int d0 = 0; d0 < 2; ++d0) ost[orow * 64 + d0 * 32 + r32] = (h16)(o[d0][r] * rl); }
        BAR_LDS();
#pragma unroll
        for (int ps = 0; ps < 2; ++ps) { const int row = 64 * ps + frow, wt = row >> 5, tr = row & 31; const LAS h16* pf = (const LAS h16*)(lds + MO_OST) + wt * 2048 + tr * 64 + fc8 * 8; const LAS h16* pb = pf + 4 * 2048;
          const h16x8 af = *(const LAS h16x8*)pf, ab = *(const LAS h16x8*)pb;
          float x[8]; float ss = 0.f;
#pragma unroll
          for (int j = 0; j < 8; ++j) { x[j] = (float)af[j] + (float)ab[j]; ss += x[j] * x[j]; }
          ss = oct_sum(ss);
          const float rn = __builtin_amdgcn_rsqf(ss * (1.f / 64.f) + EPS); const LAS float* gh = (const LAS float*)(lds + MO_GH) + h * 64 + fc8 * 8;
          const h16x8 co = ps ? co1 : co0, cz = ps ? cz1 : cz0;
          float y[8];
#pragma unroll
          for (int j = 0; j < 8; ++j) y[j] = sigmf((float)co[j]) * (x[j] * rn * gh[j]) * siluf((float)cz[j]);
          u32x4 w0; w0.x = cvtpk_h(y[0], y[1]); w0.y = cvtpk_h(y[2], y[3]); w0.z = cvtpk_h(y[4], y[5]); w0.w = cvtpk_h(y[6], y[7]);
          *(GAS u32x4*)(Y + (rb + row) * D + 768 + h * 64 + fc8 * 8) = w0; }
        BAR_LDS();
        if (!more) break;
        b = nb; h = nh; tc = ntcv;
    }
}
#undef H8
}
__device__ __forceinline__ int q_first(Frame& F, gu32* head, const bool have_pre = false, const unsigned pre = 0u) {
    volatile LAS int* slot = (volatile LAS int*)(F.lds + MISC_OFF + 256);
    __syncthreads();
    if (F.tid == 0) *slot = have_pre ? (int)pre : (int)__hip_atomic_fetch_add(head, 1u, RLX_AGENT);
    __syncthreads();
    return __builtin_amdgcn_readfirstlane(*slot);
}
__device__ __forceinline__ void ph_mixers(Frame& F, int l, int rep, const bool have_pre = false, const unsigned pre = 0u) {
    unsigned char* ws = F.p.ws; const bool ctx_out = l < DEPTH - 1;
    const int pm_ = rep ? PROBE_MIX : 15;
    const int n_scan = (FAST_MLSTM && (pm_ & 1)) ? 128 : 0;
    const int n_attn = (FAST_ATTN && (pm_ & 2)) ? 1024 : 0, n_attc = (FAST_ATTN && ctx_out && (pm_ & 2)) ? 128 : 0;
    const int n_gmlp = (FAST_GMLP && (pm_ & 4)) ? (ctx_out ? MROWS / 128 : MLAT / 128) : 0;
    const int ntc = ctx_out ? 18 : 16, n_mout = (FAST_MLSTM && (pm_ & 8)) ? 64 * ntc : 0;
    const int o_attn = n_scan, o_attc = o_attn + n_attn, o_gmlp = o_attc + n_attc, o_mout = o_gmlp + n_gmlp, o_end = o_mout + n_mout;
    gu32* head = F.ctl + CW_QUEUE + 64 * (l + 4 * rep); gu32* chain = F.ctl + CW_CHAIN + 64 * (l * 128);
    if (F.tid == 0) *(volatile LAS unsigned*)(F.lds + MISC_OFF + 320) = 0u;
    const float mfx = __int_as_float(__builtin_amdgcn_readfirstlane(__float_as_int(*(const GAS float*)(ws + WS_ROPE + 8192 + 4 * l))));
    int u = q_first(F, head, have_pre, pre); bool warm = false;
    while (u < o_end) {
        if (u >= o_mout) {
            int tidm = F.tid; asm volatile("" : "+v"(tidm)); unsigned lo2 = 0; asm volatile("" : "+s"(lo2)); LAS unsigned char* ldsm = F.lds + lo2; unsigned char* wsm = F.p.ws; asm volatile("" : "+s"(wsm));
            mx::mlstm_out_loop(wsm, (h16*)F.p.out, F.p.ghead + l * 256, u, o_mout, o_end, ntc, ctx_out, head, chain, (volatile LAS unsigned*)(F.lds + MISC_OFF + 320), (volatile LAS int*)(F.lds + MISC_OFF + 256), ldsm, (char*)ldsm, tidm);
            break;
        }
        unsigned nxt = 0u;
        if (F.tid == 0) nxt = __hip_atomic_fetch_add(head, 1u, RLX_AGENT);
        int tid = F.tid; asm volatile("" : "+v"(tid));
        unsigned lofs = 0; asm volatile("" : "+s"(lofs)); LAS unsigned char* lds = F.lds + lofs;
        { unsigned char* w2 = F.p.ws; asm volatile("" : "+s"(w2)); ws = w2; }
        if (u < o_attn) {
            mx::scan_unit(ws, u >> 3, (u >> 1) & 3, u & 1, chain + 64 * u, lds, tid); warm = false;
        } else if (u < o_gmlp) {
            const bool isl = u < o_attc; const int a = isl ? u - o_attn : u - o_attc;
            const int qb = isl ? (a & 7) : 0, g = isl ? (a >> 3) : a, hq = g & 3, kvh = (g >> 2) & 1, b = g >> 3, h = kvh * 4 + hq;
            const h16* Q = (const h16*)(ws + WS_Q); const h16* KB = (const h16*)(ws + WS_KB); const h16* VB = (const h16*)(ws + WS_VB); const h16* BZ = (const h16*)(ws + WS_BZ); h16* Y = (h16*)F.p.out;
            const size_t row0 = isl ? (size_t)b * SEQ + qb * 256 : (size_t)MLAT + (size_t)b * CTXL; const size_t kvo = ((size_t)(b * 2 + kvh) * NKEY) * 64;
            const attn_body::Seam sm{o_attn, o_attc, o_gmlp, Q, KB, VB, (volatile LAS int*)(F.lds + MISC_OFF + 384)};
            if (mfx <= -1.f) warm = attn_body::attn_unit<8, true>(Q + row0 * 512 + h * 64, KB + kvo, VB + kvo, isl ? NKEY / 64 : CTXL / 64, Y + row0 * D + 256 + h * 64, BZ + row0 * 512 + h * 64, (char*)lds, tid, mfx, warm, nxt, sm);
            else warm = attn_body::attn_unit<8, false>(Q + row0 * 512 + h * 64, KB + kvo, VB + kvo, isl ? NKEY / 64 : CTXL / 64, Y + row0 * D + 256 + h * 64, BZ + row0 * 512 + h * 64, (char*)lds, tid, mfx, warm, nxt, sm);
        } else if (u < o_mout) {
            mx::gmlp_unit(ws, (h16*)F.p.out, (const h16*)(ws + WS_WS16) + (size_t)l * 4 * 128 * 128, F.p.bsp + l * 512, (size_t)(u - o_gmlp) * 128, lds, tid); warm = false;
        }
        { volatile LAS int* slot = (volatile LAS int*)(F.lds + MISC_OFF + 256);
          BAR_LDS(); if (F.tid == 0) *slot = (int)nxt; BAR_LDS(); u = __builtin_amdgcn_readfirstlane(*slot); }
    }
}
constexpr int PH_FINAL = 2 + 3 * DEPTH, NPHASE = PH_FINAL + 1;
struct Args { Ptrs p; int ph_lo, ph_hi, li, pad; };

__device__ __forceinline__ void ph_inproj(Frame& F, int l, bool dry, bool nost) {
    unsigned char* ws = F.p.ws;
    pg8::Gemm g{(const h16*)(ws + WS_XS), (const h16*)(ws + WS_WINT) + (size_t)l * NPAD * D, MROWS, NPAD, D};
    pg8::StaticOrder S; S.init(MROWS, NPAD, F.G, F.bid);
    { const float* rt = (const float*)(ws + WS_ROPE); LAS float* rl = (LAS float*)(F.lds + ROPE_LDS_OFF); for (int i = F.tid; i < 2048; i += NTHREADS) rl[i] = *(const GAS float*)(rt + i); __syncthreads(); }
    EpiIn E{(unsigned)(WS_SHW + (size_t)l * 17 * NPAD * 4), F.p.gq + l * 64, F.p.gk + l * 64, F.p.bgates + l * 16, ws, nost ? nullptr : ws, (const LAS float*)(F.lds + ROPE_LDS_OFF)};
#if PROBE_BF16
    if (dry) pg8::gemm_phase<EpiIn, true, true, true>(F.lds, F.tid, g, S, E, dry); else
#endif
    pg8::gemm_phase<EpiIn, true, true>(F.lds, F.tid, g, S, E, dry);
}
#ifndef OUT_HALF_TAIL
#define OUT_HALF_TAIL 1
#endif
__device__ __forceinline__ void ph_outproj(Frame& F, int l, float gscale, bool dry) {
    unsigned char* ws = F.p.ws; const bool last = l == DEPTH - 1; const int Mr = last ? MLAT : MROWS;
    pg8::Gemm g{(const h16*)F.p.out, (const h16*)(ws + WS_WOT) + (size_t)l * D * D, Mr, D, D};
    pg8::StaticOrder S; S.init(Mr, D, F.G, F.bid);
    EpiOut E{(unsigned)(WS_MOD + ((size_t)l * 17 * 3072 + 2048) * 4), last ? 0u : (unsigned)(WS_AMOD + (size_t)(l + 1) * 17 * 1024 * 4), ws, gscale, false};
    const int nfull = (S.nwg / F.G) * F.G, rem = S.nwg - nfull; const bool split = OUT_HALF_TAIL && !dry && rem > 0 && 2 * rem <= F.G;
    if (split) S.lim = nfull;
    pg8::gemm_phase<EpiOut, true, true>(F.lds, F.tid, g, S, E, dry);
    if (split) { pg8::HalfOrder H{S, nfull}; EpiOut E2 = E; E2.half = true; pg8::gemm_phase<EpiOut, true, true, false, true, pg8::HalfOrder>(F.lds, F.tid, g, H, E2, false); }
}

__global__ void __launch_bounds__(NTHREADS, 2) mega(Args a) {
    extern __shared__ __attribute__((aligned(16))) unsigned char lds[];
    Frame F; F.lds = (LAS unsigned char*)lds; F.tid = threadIdx.x; F.lane = F.tid & 63; F.wave = __builtin_amdgcn_readfirstlane(F.tid >> 6); F.G = gridDim.x; F.p = a.p;
    F.ctl = (gu32*)(a.p.ws + WS_CTL);
    volatile LAS unsigned* MISC = (volatile LAS unsigned*)(F.lds + MISC_OFF);
    for (int u = F.tid; u < 256; u += NTHREADS) MISC[u] = 0u;
    __syncthreads();
    XcdBarrier bar; bar.bar = (unsigned*)(F.ctl + CW_BAR) + a.li * XCD_BAR_WORDS; bar.x = 0; bar.st = nullptr;
    if (a.ph_hi - a.ph_lo > 1) bar = xcd_barrier_post((unsigned*)(F.ctl + CW_BAR) + a.li * XCD_BAR_WORDS, MISC + 8);
    const int wave0 = __builtin_amdgcn_readfirstlane(threadIdx.x >> 6);
    unsigned pre_tk = 0u; bool have_pre = false;
    for (int pp = 2 * a.ph_lo; pp < 2 * a.ph_hi; ++pp) {
        const int ph = pp >> 1, rep = pp & 1;
        const int kk = (ph >= 2 && ph < PH_FINAL) ? (ph - 2) % 3 : 3; const bool dupk = ((PROBE_DUP >> kk) & 1) != 0 && ph != PH_FINAL;
        if (!dupk && rep == 1) continue;
        { int wv = wave0; asm volatile("" : "+s"(wv)); int ln = (int)__builtin_amdgcn_mbcnt_hi(~0u, __builtin_amdgcn_mbcnt_lo(~0u, 0u)); asm volatile("" : "+v"(ln)); const int t = wv * 64 + ln; F.tid = t; F.lane = ln; F.wave = wv;
          int bx = blockIdx.x; asm volatile("" : "+s"(bx)); F.bid = bx;
          unsigned char* w = a.p.ws; asm volatile("" : "+s"(w)); F.p.ws = w;
          unsigned lb = 0; asm volatile("" : "+s"(lb)); F.lds = (LAS unsigned char*)lds + lb; }
        if (ph == 0) p0ab(F);
        else if (ph == 1) p0c(F);
        else if (ph == PH_FINAL) p_final(F);
        else { const int l = (ph - 2) / 3, k = (ph - 2) % 3;
            const bool dup = ((PROBE_DUP >> k) & 1) != 0;
            const bool dry = PROBE_NOEPI && dup && rep == 0;
            if (k == 0) { if (!PROBE_DUP && ph + 1 < a.ph_hi) { if (threadIdx.x == 0) pre_tk = __hip_atomic_fetch_add(F.ctl + CW_QUEUE + 64 * l, 1u, __ATOMIC_RELAXED, __HIP_MEMORY_SCOPE_AGENT); have_pre = true; }
                ph_inproj(F, l, dry, PROBE_NOSTORE && dup && rep == 0); }
            else if (k == 1) { ph_mixers(F, l, rep, have_pre, pre_tk); have_pre = false; }
            else ph_outproj(F, l, (dup && rep == 0) ? 0.f : 1.f, dry); }
        if (!(ph == a.ph_hi - 1 && (rep == 1 || !dupk))) xcd_barrier(bar);
#if PROBE_XBAR
        if (ph == 1) { for (int xb = 0; xb < PROBE_XBAR; ++xb) xcd_barrier(bar); }
#endif
    }
}

extern "C" void kernel_launch(void* const* d_in, const int* in_sizes, int n_in, void* d_out, int out_size, void* d_ws, size_t ws_size, hipStream_t stream) {
    static int grid = 0;
    if (grid == 0) {
        if (n_in != 16 || ws_size < WS_END) { fprintf(stderr, "kernel_launch: unexpected n_in %d / ws %zu (need %zu)\n", n_in, ws_size, (size_t)WS_END); grid = -1; return; }
        int dev = 0, cus = 0, per_cu = 0;
        hipGetDevice(&dev); hipDeviceGetAttribute(&cus, hipDeviceAttributeMultiprocessorCount, dev);
        if (hipFuncSetAttribute((const void*)mega, hipFuncAttributeMaxDynamicSharedMemorySize, LDS_BYTES) != hipSuccess) { fprintf(stderr, "kernel_launch: hipFuncSetAttribute failed\n"); grid = -1; return; }
        hipOccupancyMaxActiveBlocksPerMultiprocessor(&per_cu, (const void*)mega, NTHREADS, LDS_BYTES);
        (void)hipGetLastError();
        if (per_cu < 1) fprintf(stderr, "kernel_launch: occupancy query says %d blocks/CU\n", per_cu);
        grid = cus;
    }
    if (grid < 0) return;
    hipMemsetAsync((char*)d_ws + WS_CTL, 0, CTL_ZERO_BYTES, stream);
    Args a{};
    const float** pp = (const float**)&a.p;
    for (int i = 0; i < 16; ++i) pp[i] = (const float*)d_in[i];
    a.p.out = (float*)d_out; a.p.ws = (unsigned char*)d_ws;
    int li = 0;
    auto launch = [&](int lo, int hi) { a.ph_lo = lo; a.ph_hi = hi; a.li = (hi - lo > 1) ? li++ : 0; hipLaunchKernelGGL(mega, dim3(grid), dim3(NTHREADS), LDS_BYTES, stream, a); };
#if ONE_LAUNCH
    launch(0, NPHASE);
#else
    launch(0, 1); launch(1, 2);
    for (int l = 0; l < DEPTH; ++l) {
        launch(2 + 3 * l, 3 + 3 * l);
        launch(3 + 3 * l, 4 + 3 * l);
        launch(4 + 3 * l, 5 + 3 * l);
    }
    launch(PH_FINAL, NPHASE);
#endif
}
```
